# Optimizing an MI355X kernel written in HIP

```python
import math
import jax, jax.numpy as jnp
from jax import lax
import numpy as np

D_MODEL = 1024
BATCH = 4
SEQ = 4096
DEPTH = 2

GRID_W = 64
QBLK = 128
EPS = 1e-6
ROPE_THETA = 10000.0

DIFF_HEADS = 4
DIFF_HD = 64
GQA_HEADS = 8
GQA_KV_HEADS = 2
GQA_HD = 64
MLA_HEADS = 8
MLA_Q_RANK = 256
MLA_KV_RANK = 128
MLA_NOPE = 64
MLA_ROPE = 32
MLA_V = 64
S5_GROUPS = 32
S5_GROUP_CH = 16
S5_STATE = 64
S5_WIDTH = S5_GROUPS * S5_GROUP_CH
FFN_HIDDEN = 4 * D_MODEL
N_BRANCH = 4

A_Q = DIFF_HEADS * 2 * DIFF_HD
A_K = DIFF_HEADS * 2 * DIFF_HD
A_V = DIFF_HEADS * 2 * DIFF_HD
B_Q = GQA_HEADS * GQA_HD
B_KV = GQA_KV_HEADS * GQA_HD
IN_SIZES = (A_Q, A_K, A_V, B_Q, B_KV, B_KV, MLA_Q_RANK, MLA_KV_RANK, MLA_ROPE, S5_WIDTH)
IN_WIDTH = sum(IN_SIZES)
BR_A = DIFF_HEADS * 2 * DIFF_HD
BR_B = GQA_HEADS * GQA_HD
BR_C = MLA_HEADS * MLA_V
BR_D = S5_WIDTH

kernel_name = "hybrid_gated_parallel_encoder"


def _rmsnorm(x, g):
    xf = x.astype(jnp.float32)
    y = xf * lax.rsqrt(jnp.mean(xf * xf, axis=-1, keepdims=True) + EPS)
    return y.astype(x.dtype) * g


def _rope_angles(pos, dim):
    inv = ROPE_THETA ** (-jnp.arange(0, dim, 2, dtype=jnp.float32) / dim)
    ang = pos.astype(jnp.float32)[:, None] * inv[None, :]
    return jnp.cos(ang), jnp.sin(ang)


def _apply_rope(x, cos, sin):
    half = x.shape[-1] // 2
    extra = x.ndim - 3
    c = cos.reshape(cos.shape[:1] + (1,) * extra + cos.shape[1:]).astype(x.dtype)
    s = sin.reshape(sin.shape[:1] + (1,) * extra + sin.shape[1:]).astype(x.dtype)
    x1, x2 = x[..., :half], x[..., half:]
    return jnp.concatenate([x1 * c - x2 * s, x1 * s + x2 * c], axis=-1)


def _sweep_queries(block_fn, qs):
    B, L = qs[0].shape[:2]
    nb = L // QBLK
    split = lambda a: jnp.moveaxis(a.reshape((B, nb, QBLK) + a.shape[2:]), 1, 0)
    out = lax.map(lambda args: block_fn(args[0], *args[1]),
                  (jnp.arange(nb), tuple(split(a) for a in qs)))
    out = jnp.moveaxis(out, 0, 1)
    return out.reshape((B, L) + out.shape[3:])


def _diff_attention(q, k, v, lq1, lk1, lq2, lk2, subln, layer_idx):
    B, L, H = q.shape[:3]
    f32 = jnp.float32
    lam_init = 0.8 - 0.6 * math.exp(-0.3 * layer_idx)
    lam = (jnp.exp(jnp.sum(lq1.astype(f32) * lk1.astype(f32)))
           - jnp.exp(jnp.sum(lq2.astype(f32) * lk2.astype(f32))) + lam_init)
    slopes = jnp.asarray(2.0 ** (-8.0 * np.arange(1, H + 1) / H), dtype=f32)
    kpos = jnp.arange(L, dtype=f32)
    scale = DIFF_HD ** -0.5

    def block(i, qb):
        s = jnp.einsum('bqhcd,bkhcd->bhcqk', qb, k).astype(f32) * scale
        qpos = (i * QBLK + jnp.arange(QBLK)).astype(f32)
        bias = -slopes[:, None, None, None] * jnp.abs(qpos[:, None] - kpos[None, :])
        p = jax.nn.softmax(s + bias, axis=-1)
        w = p[:, :, 0] - lam * p[:, :, 1]
        return jnp.einsum('bhqk,bkhe->bqhe', w.astype(v.dtype), v)

    o = _sweep_queries(block, (q,))
    o = _rmsnorm(o, subln) * (1.0 - lam_init)
    return o.reshape(B, L, H * 2 * DIFF_HD)


def _gqa_axial(q, k, v, gq, gk):
    B, L = q.shape[:2]
    rows = L // GRID_W
    row = jnp.repeat(jnp.arange(rows), GRID_W)
    col = jnp.tile(jnp.arange(GRID_W), rows)
    half = GQA_HD // 2
    rc, rs = _rope_angles(row, half)
    cc, cs = _rope_angles(col, half)
    rot = lambda t: jnp.concatenate([_apply_rope(t[..., :half], rc, rs),
                                     _apply_rope(t[..., half:], cc, cs)], axis=-1)
    q = rot(_rmsnorm(q, gq))
    k = rot(_rmsnorm(k, gk))
    q = q.reshape(B, L, GQA_KV_HEADS, GQA_HEADS // GQA_KV_HEADS, GQA_HD)
    scale = GQA_HD ** -0.5

    def block(i, qb):
        s = jnp.einsum('bqgrd,bkgd->bgrqk', qb, k).astype(jnp.float32) * scale
        p = jax.nn.softmax(s, axis=-1)
        return jnp.einsum('bgrqk,bkgd->bqgrd', p.astype(v.dtype), v)

    o = _sweep_queries(block, (q,))
    return o.reshape(B, L, GQA_HEADS * GQA_HD)


def _mla(cq, ckv, kr, gq, gkv, w_uq, w_ukv):
    B, L = cq.shape[:2]
    cos, sin = _rope_angles(jnp.arange(L), MLA_ROPE)
    q = (_rmsnorm(cq, gq) @ w_uq).reshape(B, L, MLA_HEADS, MLA_NOPE + MLA_ROPE)
    kv = (_rmsnorm(ckv, gkv) @ w_ukv).reshape(B, L, MLA_HEADS, MLA_NOPE + MLA_V)
    q_nope = q[..., :MLA_NOPE]
    q_rope = _apply_rope(q[..., MLA_NOPE:], cos, sin)
    k_nope, v = kv[..., :MLA_NOPE], kv[..., MLA_NOPE:]
    k_rope = _apply_rope(kr, cos, sin)
    scale = (MLA_NOPE + MLA_ROPE) ** -0.5

    def block(i, qn, qr):
        s = (jnp.einsum('bqhd,bkhd->bhqk', qn, k_nope)
             + jnp.einsum('bqhr,bkr->bhqk', qr, k_rope))
        p = jax.nn.softmax(s.astype(jnp.float32) * scale, axis=-1)
        return jnp.einsum('bhqk,bkhd->bqhd', p.astype(v.dtype), v)

    o = _sweep_queries(block, (q_nope, q_rope))
    return o.reshape(B, L, MLA_HEADS * MLA_V)


def _complex_affine_combine(e1, e2):
    a1r, a1i, b1r, b1i = e1
    a2r, a2i, b2r, b2i = e2
    return (a2r * a1r - a2i * a1i,
            a2r * a1i + a2i * a1r,
            a2r * b1r - a2i * b1i + b2r,
            a2r * b1i + a2i * b1r + b2i)


def _s5_direction(u, a_re, a_im, log_dt, b_re, b_im, c_re, c_im, reverse):
    f32 = jnp.float32
    L = u.shape[1]
    a_re = jnp.minimum(a_re.astype(f32), -1e-4)
    a_im = a_im.astype(f32)
    dt = jnp.exp(log_dt.astype(f32))[:, None]
    mag = jnp.exp(a_re * dt)
    lb_re = mag * jnp.cos(a_im * dt)
    lb_im = mag * jnp.sin(a_im * dt)
    den = a_re * a_re + a_im * a_im
    n_re = lb_re - 1.0
    f_re = (n_re * a_re + lb_im * a_im) / den
    f_im = (lb_im * a_re - n_re * a_im) / den
    b_re, b_im = b_re.astype(f32), b_im.astype(f32)
    bb_re = f_re[..., None] * b_re - f_im[..., None] * b_im
    bb_im = f_re[..., None] * b_im + f_im[..., None] * b_re
    x_re = jnp.einsum('blgh,gph->lbgp', u, bb_re)
    x_im = jnp.einsum('blgh,gph->lbgp', u, bb_im)
    at_re = jnp.broadcast_to(lb_re, (L, 1) + lb_re.shape)
    at_im = jnp.broadcast_to(lb_im, (L, 1) + lb_im.shape)
    _, _, s_re, s_im = lax.associative_scan(_complex_affine_combine,
                                            (at_re, at_im, x_re, x_im),
                                            reverse=reverse, axis=0)
    return (jnp.einsum('lbgp,ghp->blgh', s_re, c_re.astype(f32))
            - jnp.einsum('lbgp,ghp->blgh', s_im, c_im.astype(f32)))


def _s5_mixer(u, a_re, a_im, log_dt, b_re, b_im, c_re, c_im, d, w_glu):
    B, L = u.shape[:2]
    ug = u.reshape(B, L, S5_GROUPS, S5_GROUP_CH)
    uf = ug.astype(jnp.float32)
    y = (_s5_direction(uf, a_re[0], a_im[0], log_dt[0], b_re[0], b_im[0], c_re[0], c_im[0], False)
         + _s5_direction(uf, a_re[1], a_im[1], log_dt[1], b_re[1], b_im[1], c_re[1], c_im[1], True))
    y = y.astype(u.dtype) + d * ug
    y = jax.nn.gelu(y.reshape(B, L, S5_WIDTH))
    h = y @ w_glu
    return h[..., :S5_WIDTH] * jax.nn.sigmoid(h[..., S5_WIDTH:])


def setup_inputs(seed: int = 0) -> dict:
    key = jax.random.key(seed)
    ks = iter(jax.random.split(key, 48))
    nrm = lambda shape, scale: jax.random.normal(next(ks), shape, jnp.float32) * scale
    gain = lambda shape: 1.0 + 0.05 * jax.random.normal(next(ks), shape, jnp.float32)
    D, G, P, H = D_MODEL, S5_GROUPS, S5_STATE, S5_GROUP_CH
    a_im_base = jnp.pi * jnp.arange(P, dtype=jnp.float32)
    return {
        "x": nrm((BATCH, SEQ, D), 1.0),
        "norm_pre_mix": gain((DEPTH, D)),
        "norm_post_mix": gain((DEPTH, D)),
        "norm_pre_ffn": gain((DEPTH, D)),
        "norm_post_ffn": gain((DEPTH, D)),
        "w_in": nrm((DEPTH, D, IN_WIDTH), D ** -0.5),
        "w_gate": nrm((DEPTH, D, N_BRANCH * D), D ** -0.5),
        "diff_lam_q1": nrm((DEPTH, DIFF_HD), 0.1),
        "diff_lam_k1": nrm((DEPTH, DIFF_HD), 0.1),
        "diff_lam_q2": nrm((DEPTH, DIFF_HD), 0.1),
        "diff_lam_k2": nrm((DEPTH, DIFF_HD), 0.1),
        "diff_subln": gain((DEPTH, 2 * DIFF_HD)),
        "gqa_q_norm": gain((DEPTH, GQA_HD)),
        "gqa_k_norm": gain((DEPTH, GQA_HD)),
        "mla_q_norm": gain((DEPTH, MLA_Q_RANK)),
        "mla_kv_norm": gain((DEPTH, MLA_KV_RANK)),
        "mla_w_uq": nrm((DEPTH, MLA_Q_RANK, MLA_HEADS * (MLA_NOPE + MLA_ROPE)), MLA_Q_RANK ** -0.5),
        "mla_w_ukv": nrm((DEPTH, MLA_KV_RANK, MLA_HEADS * (MLA_NOPE + MLA_V)), MLA_KV_RANK ** -0.5),
        "s5_a_re": -0.5 + nrm((DEPTH, 2, G, P), 0.01),
        "s5_a_im": a_im_base + nrm((DEPTH, 2, G, P), 0.01),
        "s5_log_dt": jax.random.uniform(next(ks), (DEPTH, 2, G), jnp.float32,
                                        math.log(1e-3), math.log(1e-1)),
        "s5_b_re": nrm((DEPTH, 2, G, P, H), (2.0 * H) ** -0.5),
        "s5_b_im": nrm((DEPTH, 2, G, P, H), (2.0 * H) ** -0.5),
        "s5_c_re": nrm((DEPTH, 2, G, H, P), P ** -0.5),
        "s5_c_im": nrm((DEPTH, 2, G, H, P), P ** -0.5),
        "s5_d": nrm((DEPTH, G, H), 1.0),
        "s5_w_glu": nrm((DEPTH, S5_WIDTH, 2 * S5_WIDTH), S5_WIDTH ** -0.5),
        "w_br_a": nrm((DEPTH, BR_A, D), BR_A ** -0.5),
        "w_br_b": nrm((DEPTH, BR_B, D), BR_B ** -0.5),
        "w_br_c": nrm((DEPTH, BR_C, D), BR_C ** -0.5),
        "w_br_d": nrm((DEPTH, BR_D, D), BR_D ** -0.5),
        "w_out": nrm((DEPTH, D, D), D ** -0.5),
        "w_ffn_in": nrm((DEPTH, D, FFN_HIDDEN), D ** -0.5),
        "w_ffn_out": nrm((DEPTH, FFN_HIDDEN, D), FFN_HIDDEN ** -0.5),
    }


def reference(x, norm_pre_mix, norm_post_mix, norm_pre_ffn, norm_post_ffn, w_in, w_gate,
              diff_lam_q1, diff_lam_k1, diff_lam_q2, diff_lam_k2, diff_subln,
              gqa_q_norm, gqa_k_norm, mla_q_norm, mla_kv_norm, mla_w_uq, mla_w_ukv,
              s5_a_re, s5_a_im, s5_log_dt, s5_b_re, s5_b_im, s5_c_re, s5_c_im, s5_d, s5_w_glu,
              w_br_a, w_br_b, w_br_c, w_br_d, w_out, w_ffn_in, w_ffn_out):
    B, L, _ = x.shape
    split_idx = [int(v) for v in np.cumsum(IN_SIZES)[:-1]]
    h = x
    for i in range(DEPTH):
        xn = _rmsnorm(h, norm_pre_mix[i])
        proj = xn @ w_in[i]
        a_q, a_k, a_v, b_q, b_k, b_v, c_q, c_kv, c_kr, d_u = jnp.split(proj, split_idx, axis=-1)
        ya = _diff_attention(a_q.reshape(B, L, DIFF_HEADS, 2, DIFF_HD),
                             a_k.reshape(B, L, DIFF_HEADS, 2, DIFF_HD),
                             a_v.reshape(B, L, DIFF_HEADS, 2 * DIFF_HD),
                             diff_lam_q1[i], diff_lam_k1[i], diff_lam_q2[i], diff_lam_k2[i],
                             diff_subln[i], i)
        yb = _gqa_axial(b_q.reshape(B, L, GQA_HEADS, GQA_HD),
                        b_k.reshape(B, L, GQA_KV_HEADS, GQA_HD),
                        b_v.reshape(B, L, GQA_KV_HEADS, GQA_HD),
                        gqa_q_norm[i], gqa_k_norm[i])
        yc = _mla(c_q, c_kv, c_kr, mla_q_norm[i], mla_kv_norm[i], mla_w_uq[i], mla_w_ukv[i])
        yd = _s5_mixer(d_u, s5_a_re[i], s5_a_im[i], s5_log_dt[i], s5_b_re[i], s5_b_im[i],
                       s5_c_re[i], s5_c_im[i], s5_d[i], s5_w_glu[i])
        gates = jax.nn.sigmoid(xn @ w_gate[i]).reshape(B, L, N_BRANCH, D_MODEL)
        mixed = (gates[:, :, 0] * (ya @ w_br_a[i]) + gates[:, :, 1] * (yb @ w_br_b[i])
                 + gates[:, :, 2] * (yc @ w_br_c[i]) + gates[:, :, 3] * (yd @ w_br_d[i]))
        h = h + _rmsnorm(mixed @ w_out[i], norm_post_mix[i])
        fn = _rmsnorm(h, norm_pre_ffn[i])
        f = jnp.square(jax.nn.relu(fn @ w_ffn_in[i])) @ w_ffn_out[i]
        h = h + _rmsnorm(f, norm_post_ffn[i])
    return h
```

```cpp
#include <hip/hip_runtime.h>
#include <hip/hip_cooperative_groups.h>
#include <cstdio>
#include <cstdint>
namespace cg = cooperative_groups;
#ifndef PHMASK
#define PHMASK 0x7ff
#endif
#define PHON(k) ((PHMASK >> (k)) & 1)
#ifndef MK_ONE_LAUNCH
#define MK_ONE_LAUNCH 1
#endif
namespace pg8 {
#define PG8_LAS __attribute__((address_space(3)))
typedef unsigned short bf16_t;
typedef short bf16x8 __attribute__((ext_vector_type(8)));
typedef float f32x4 __attribute__((ext_vector_type(4)));
typedef unsigned u32x4 __attribute__((ext_vector_type(4)));
constexpr int BM = 256, BK = 64, HALF = 128, HTB = HALF * BK * 2  , STAGE_BYTES = 8 * HTB, NXCD = 8, WGM = 8;

__host__ __device__ __forceinline__ int lds_byte(int r, int c) { const int st = (r >> 4) * 2 + (c >> 5), rr = r & 15, cc = c & 31, ob = rr * 64 + cc * 2; return st * 1024 + (ob ^ (((ob >> 9) & 1) << 5)); }
__host__ __device__ __forceinline__ void stage_rc(int b, int& R, int& C) { const int st = b / 1024, sb = b % 1024, swz = sb ^ (((sb >> 9) & 1) << 5); R = (st >> 1) * 16 + swz / 64; C = (st & 1) * 32 + (swz % 64) / 2; }
__host__ __device__ __forceinline__ int perm32(int rho) { const int n = rho >> 4, i = rho & 15; return 8 * (i >> 2) + 4 * n + (i & 3); }

struct Unit { int pm, pn; };
struct Gemm { const bf16_t* A; const bf16_t* Bt; int M, N, K, lda, ldb; };

struct StaticOrder {
    int nM, nN, nwg, G, c;
    __host__ __device__ void init(int M, int N, int G_, int c_) { nM = M / BM; nN = N / BM; nwg = nM * nN; G = G_; c = c_; }
    __host__ __device__ bool next(int i, Unit& u) const {
        const long L = (long)i * G + c; if (L >= nwg) return false;
        int wgid = (int)L; { const int q = nwg / NXCD, r = nwg % NXCD, xcd = wgid % NXCD, off = wgid / NXCD; wgid = (xcd < r ? xcd * (q + 1) : r * (q + 1) + (xcd - r) * q) + off; }
        const int nig = WGM * nN, gid = wgid / nig, fm = gid * WGM, gsz = (nM - fm) < WGM ? (nM - fm) : WGM;
        u.pm = fm + ((wgid % nig) % gsz); u.pn = (wgid % nig) / gsz; return true;
    }
    __device__ __forceinline__ void a_ready(const Unit&) const {}
    __device__ __forceinline__ void done(const Unit&) const {}
};

__device__ __forceinline__ unsigned cvt_pk_bf16(float lo, float hi) { unsigned r; asm volatile("v_cvt_pk_bf16_f32 %0, %1, %2" : "=v"(r) : "v"(lo), "v"(hi)); return r; }
template <class Epi, class Sched, bool ALIGN_EPI = false, bool SP2 = false>
__device__ __forceinline__ void gemm_phase(PG8_LAS unsigned char* lds, const Gemm g, const Sched& S, const Epi& E) {
    int tid_ = threadIdx.x; asm volatile("" : "+v"(tid_));
    const int tid = tid_, wid = __builtin_amdgcn_readfirstlane(tid >> 6), lane = tid & 63, wr = wid >> 2, wc = wid & 3, fr = lane & 15, fq = lane >> 4;
    const int K = g.K, nt = K / BK;
    unsigned voffA[2], voffB[2];
#pragma unroll
    for (int i = 0; i < 2; ++i) { int R, C; stage_rc(tid * 16 + i * 8192, R, C); const int Rb = Epi::PERM ? ((R & ~31) + perm32(R & 31)) : R;
        voffA[i] = (unsigned)(R * g.lda + C) * 2u; voffB[i] = (unsigned)(Rb * g.ldb + C) * 2u; }
    const size_t kstep = (size_t)(BK * 2);
    const size_t hstepA = (size_t)HALF * g.lda * 2, hstepB = (size_t)HALF * g.ldb * 2;
    const size_t tstepA = 2 * hstepA, tstepB = 2 * hstepB;
    const unsigned ldsw = (unsigned)wid * 1024u;
    const int aoff = lds_byte(wr * 64 + fr, fq * 8), boff = lds_byte(wc * 32 + fr, fq * 8);
#define PG8_SA(b, h) (((b) * 2 + (h)) * HTB)
#define PG8_SB(b, h) ((4 + (b) * 2 + (h)) * HTB)
#define PG8_STAGE(bufoff, gbase, voff) do { _Pragma("unroll") for (int _i = 0; _i < 2; ++_i) \
        __builtin_amdgcn_global_load_lds((const unsigned*)((const char*)(gbase) + (voff)[_i]), (PG8_LAS unsigned*)(lds + (bufoff) + ldsw + _i * 8192), 16, 0, 0); } while (0)
#define PG8_LDA(dst, b, h) do { _Pragma("unroll") for (int m = 0; m < 4; ++m) _Pragma("unroll") for (int k = 0; k < 2; ++k) dst[m][k] = *(const PG8_LAS bf16x8*)(lds + PG8_SA(b, h) + aoff + m * 2048 + k * 1024); } while (0)
#define PG8_LDB(dst, b, h) do { _Pragma("unroll") for (int n = 0; n < 2; ++n) _Pragma("unroll") for (int k = 0; k < 2; ++k) dst[n][k] = *(const PG8_LAS bf16x8*)(lds + PG8_SB(b, h) + boff + n * 2048 + k * 1024); } while (0)
#define PG8_MMA(ai, bj, At, Bt) do { __builtin_amdgcn_s_setprio(1); _Pragma("unroll") for (int m = 0; m < 4; ++m) _Pragma("unroll") for (int n = 0; n < 2; ++n) _Pragma("unroll") for (int k = 0; k < 2; ++k) \
        acc[ai][bj][m][n] = __builtin_amdgcn_mfma_f32_16x16x32_bf16(Bt[n][k], At[m][k], acc[ai][bj][m][n], 0, 0, 0); __builtin_amdgcn_s_setprio(0); } while (0)
#define PG8_WAIT_V(n) asm volatile("s_waitcnt vmcnt(" #n ")" ::: "memory")
#define PG8_WAIT_L(n) asm volatile("s_waitcnt lgkmcnt(" #n ")" ::: "memory")
#define PG8_BAR __builtin_amdgcn_s_barrier()
#define PG8_SCHED __builtin_amdgcn_sched_barrier(0)
    Unit cur, nxt; int ui = 0;
    if (!S.next(0, cur)) return;
    f32x4 acc[2][2][4][2];
#pragma unroll
    for (int a = 0; a < 2; ++a)
#pragma unroll
        for (int b = 0; b < 2; ++b)
#pragma unroll
            for (int m = 0; m < 4; ++m)
#pragma unroll
                for (int n = 0; n < 2; ++n) acc[a][b][m][n] = (f32x4){0.f, 0.f, 0.f, 0.f};
    bf16x8 At[4][2], B0[2][2], B1[2][2];
    const char* cA = (const char*)g.A + (size_t)cur.pm * tstepA; const char* cB = (const char*)g.Bt + (size_t)cur.pn * tstepB;
    S.a_ready(cur);
    if constexpr (SP2) {
        PG8_STAGE(PG8_SB(0, 0), cB, voffB); PG8_STAGE(PG8_SB(0, 1), cB + hstepB, voffB); PG8_STAGE(PG8_SA(0, 0), cA, voffA); PG8_STAGE(PG8_SA(0, 1), cA + hstepA, voffA);
        if (wr == 1) PG8_BAR;
        PG8_WAIT_V(2); PG8_BAR;
        PG8_STAGE(PG8_SB(1, 0), cB + kstep, voffB); PG8_STAGE(PG8_SA(1, 0), cA + kstep, voffA); PG8_STAGE(PG8_SB(1, 1), cB + hstepB + kstep, voffB);
        PG8_WAIT_V(6); PG8_BAR;
    } else {
        PG8_STAGE(PG8_SB(0, 0), cB, voffB); PG8_STAGE(PG8_SA(0, 0), cA, voffA); PG8_STAGE(PG8_SB(0, 1), cB + hstepB, voffB); PG8_STAGE(PG8_SA(0, 1), cA + hstepA, voffA);
        if (wr == 1) PG8_BAR;
        PG8_WAIT_V(4); PG8_BAR;
        PG8_STAGE(PG8_SB(1, 0), cB + kstep, voffB); PG8_STAGE(PG8_SA(1, 0), cA + kstep, voffA); PG8_STAGE(PG8_SB(1, 1), cB + hstepB + kstep, voffB);
        PG8_WAIT_V(6); PG8_BAR;
    }
    for (;;) {
        const bool has_next = S.next(ui + 1, nxt);
        const char* nA = has_next ? (const char*)g.A + (size_t)nxt.pm * tstepA : cA; const char* nB = has_next ? (const char*)g.Bt + (size_t)nxt.pn * tstepB : cB;
        for (int t = 0; t < nt; t += 2) {
            const bool last = (t == nt - 2);
            const char* a1 = cA + (size_t)(t + 1) * kstep;
            const char* a2 = last ? nA : cA + (size_t)(t + 2) * kstep; const char* b2 = last ? nB : cB + (size_t)(t + 2) * kstep;
            const char* a3 = a2 + kstep; const char* b3 = b2 + kstep;
            if (last && has_next) S.a_ready(nxt);
            if constexpr (SP2) {
            PG8_LDB(B0, 0, 0); PG8_LDB(B1, 0, 1); PG8_SCHED; PG8_LDA(At, 0, 0); PG8_STAGE(PG8_SA(1, 1), a1 + hstepA, voffA);
            PG8_WAIT_V(8); PG8_WAIT_L(0); PG8_BAR; PG8_MMA(0, 0, At, B0); PG8_MMA(0, 1, At, B1); PG8_BAR; PG8_SCHED;
            PG8_LDA(At, 0, 1); PG8_STAGE(PG8_SB(0, 0), b2, voffB); PG8_STAGE(PG8_SB(0, 1), b2 + hstepB, voffB); PG8_STAGE(PG8_SA(0, 0), a2, voffA);
            PG8_WAIT_V(8); PG8_WAIT_L(0); PG8_BAR; PG8_MMA(1, 0, At, B0); PG8_MMA(1, 1, At, B1); PG8_BAR; PG8_SCHED;
            PG8_LDB(B0, 1, 0); PG8_LDB(B1, 1, 1); PG8_SCHED; PG8_LDA(At, 1, 0); PG8_STAGE(PG8_SA(0, 1), a2 + hstepA, voffA);
            PG8_WAIT_V(8); PG8_WAIT_L(0); PG8_BAR; PG8_MMA(0, 0, At, B0); PG8_MMA(0, 1, At, B1); PG8_BAR; PG8_SCHED;
            PG8_LDA(At, 1, 1); PG8_STAGE(PG8_SB(1, 0), b3, voffB); PG8_STAGE(PG8_SB(1, 1), b3 + hstepB, voffB); PG8_STAGE(PG8_SA(1, 0), a3, voffA);
            PG8_WAIT_V(8); PG8_WAIT_L(0); PG8_BAR; PG8_MMA(1, 0, At, B0); PG8_MMA(1, 1, At, B1); PG8_BAR; PG8_SCHED;
            } else {
            PG8_LDB(B0, 0, 0); PG8_SCHED; PG8_LDA(At, 0, 0); PG8_STAGE(PG8_SA(1, 1), a1 + hstepA, voffA);
            PG8_WAIT_L(8); PG8_BAR; PG8_WAIT_L(0); PG8_MMA(0, 0, At, B0); PG8_BAR; PG8_SCHED;
            PG8_LDB(B1, 0, 1); PG8_STAGE(PG8_SB(0, 0), b2, voffB);
            PG8_BAR; PG8_WAIT_L(0); PG8_MMA(0, 1, At, B1); PG8_BAR;
            PG8_LDA(At, 0, 1); PG8_STAGE(PG8_SA(0, 0), a2, voffA);
            PG8_BAR; PG8_WAIT_L(0); PG8_MMA(1, 0, At, B0); PG8_BAR; PG8_SCHED;
            PG8_STAGE(PG8_SB(0, 1), b2 + hstepB, voffB);
            PG8_WAIT_V(6); PG8_BAR; PG8_MMA(1, 1, At, B1); PG8_BAR;
            PG8_LDB(B0, 1, 0); PG8_SCHED; PG8_LDA(At, 1, 0); PG8_STAGE(PG8_SA(0, 1), a2 + hstepA, voffA);
            PG8_WAIT_L(8); PG8_BAR; PG8_WAIT_L(0); PG8_MMA(0, 0, At, B0); PG8_BAR; PG8_SCHED;
            PG8_LDB(B1, 1, 1); PG8_STAGE(PG8_SB(1, 0), b3, voffB);
            PG8_BAR; PG8_WAIT_L(0); PG8_MMA(0, 1, At, B1); PG8_BAR;
            PG8_LDA(At, 1, 1); PG8_STAGE(PG8_SA(1, 0), a3, voffA);
            PG8_BAR; PG8_WAIT_L(0); PG8_MMA(1, 0, At, B0); PG8_BAR; PG8_SCHED;
            PG8_STAGE(PG8_SB(1, 1), b3 + hstepB, voffB);
            PG8_WAIT_V(6); PG8_BAR; PG8_MMA(1, 1, At, B1); PG8_BAR;
            }
        }
        if constexpr (ALIGN_EPI) { if (wr == 0) PG8_BAR; }
        if constexpr (!Epi::AFTER_DRAIN) { E(acc, cur, wr, wc, fr, fq); S.done(cur); }
        if (!has_next) break;
#pragma unroll
        for (int a = 0; a < 2; ++a)
#pragma unroll
            for (int b = 0; b < 2; ++b)
#pragma unroll
                for (int m = 0; m < 4; ++m)
#pragma unroll
                    for (int n = 0; n < 2; ++n) acc[a][b][m][n] = (f32x4){0.f, 0.f, 0.f, 0.f};
        cur = nxt; cA = nA; cB = nB; ++ui;
        if constexpr (ALIGN_EPI) { if (wr == 1) PG8_BAR; }
    }
    PG8_WAIT_V(0);
    if constexpr (!ALIGN_EPI) { if (wr == 0) PG8_BAR; }
    PG8_BAR;
    if constexpr (Epi::AFTER_DRAIN) { E.fused(acc, cur, wr, wc, fr, fq, lds, wid, lane); S.done(cur); }
#undef PG8_SA
#undef PG8_SB
#undef PG8_STAGE
#undef PG8_LDA
#undef PG8_LDB
#undef PG8_MMA
#undef PG8_WAIT_V
#undef PG8_WAIT_L
#undef PG8_BAR
#undef PG8_SCHED
}
}

#define LAS __attribute__((address_space(3)))
typedef unsigned short bf16_t;
typedef short bf16x8 __attribute__((ext_vector_type(8)));
typedef float f32x4 __attribute__((ext_vector_type(4)));
typedef float f32x16 __attribute__((ext_vector_type(16)));
typedef unsigned u32x4 __attribute__((ext_vector_type(4)));
typedef unsigned u32x2 __attribute__((ext_vector_type(2)));
typedef float f32x2 __attribute__((ext_vector_type(2)));

constexpr int NTOK = 16384, DMODEL = 1024, SEQL = 4096, NBATCH = 4, DEPTH_ = 2, FFH = 4096;
constexpr int LDP = 3232;
constexpr int C_AQ = 0, C_AK = 512, C_AV = 1024, C_BQ = 1536, C_BK = 2048, C_BV = 2176, C_CQ = 2304, C_CKV = 2560, C_CKR = 2688, C_DU = 2720;
constexpr int NPAD_IN = 3328;
constexpr float EPSN = 1e-6f;
constexpr float LOG2E = 1.4426950408889634f;
constexpr size_t MiB = 1u << 20;
constexpr size_t OFF_PROJ = 0, OFF_MLAQ = 101 * MiB, OFF_MLAKV = 125 * MiB, OFF_XN = 157 * MiB, OFF_YD = 189 * MiB, OFF_W = 205 * MiB, OFF_CARRY = 244 * MiB, OFF_ROPE = 248 * MiB, WS_NEED = 252 * MiB;
constexpr size_t W_IN = 0, W_GATE = 3407872, W_UQ = 7602176, W_UKV = 7798784, W_GLU = 7929856, W_BR = 8454144, W_OUT = 10551296, W_F1 = 11599872, W_F2 = 15794176;
constexpr int LDS_BYTES = 148480;
constexpr size_t OFF_CTL = 251 * MiB, CTL_BYTES = 16384;
constexpr int NPHASE = 1 + 10 * DEPTH_;
constexpr int S5_CH = 128, S5_NCH = SEQL / S5_CH;

struct Params { const float* in[34]; float* out; unsigned char* ws; int ph_lo, ph_hi; };
typedef const __attribute__((address_space(4))) Params* PPtr;

__device__ __forceinline__ float wave_sum(float v) {
#pragma unroll
    for (int o = 1; o < 64; o <<= 1) v += __shfl_xor(v, o);
    return v;
}
__device__ __forceinline__ unsigned cvtpk(float lo, float hi) { typedef __bf16 bf2 __attribute__((ext_vector_type(2))); f32x2 v = {lo, hi}; bf2 b = __builtin_convertvector(v, bf2); return __builtin_bit_cast(unsigned, b); }
__device__ __forceinline__ float bflo(unsigned w) { return __builtin_bit_cast(float, w << 16); }
__device__ __forceinline__ float bfhi(unsigned w) { return __builtin_bit_cast(float, w & 0xffff0000u); }
__device__ __forceinline__ float bf1(bf16_t h) { return __builtin_bit_cast(float, (unsigned)h << 16); }
__device__ __forceinline__ bf16_t tobf(float f) { return (bf16_t)(cvtpk(f, 0.f) & 0xffffu); }
__device__ __forceinline__ float fsigmoid(float x) { return __builtin_amdgcn_rcpf(1.f + __builtin_amdgcn_exp2f(-x * LOG2E)); }
__device__ __forceinline__ void sincos_d(double a, float& s, float& c) {
    const double k = __builtin_rint(a * 0.15915494309189535); const double r = a - k * 6.283185307179586476925;
    const double x = r * 0.25, x2 = x * x;
    const double sn = x * (1.0 + x2 * (-1.0 / 6 + x2 * (1.0 / 120 + x2 * (-1.0 / 5040 + x2 * (1.0 / 362880 + x2 * (-1.0 / 39916800 + x2 * (1.0 / 6227020800.0)))))));
    const double cs = 1.0 + x2 * (-0.5 + x2 * (1.0 / 24 + x2 * (-1.0 / 720 + x2 * (1.0 / 40320 + x2 * (-1.0 / 3628800 + x2 * (1.0 / 479001600.0 + x2 * (-1.0 / 87178291200.0)))))));
    const double s2 = 2 * sn * cs, c2 = 1 - 2 * sn * sn; s = (float)(2 * s2 * c2); c = (float)(1 - 2 * s2 * s2);
}

__device__ __forceinline__ void st16_wt(void* p, u32x4 v) { asm volatile("global_store_dwordx4 %0, %1, off sc1\n\ts_nop 4" :: "v"(p), "v"(v) : "memory"); }
template <int MODE> struct EpiB {
    static constexpr bool PERM = true, AFTER_DRAIN = false;
    bf16_t* O; int ldc; int ncols; const bf16_t* G; int ldg; const float* rope;
    __device__ __forceinline__ void operator()(const f32x4 (&acc)[2][2][4][2], const pg8::Unit& u, int wr, int wc, int fr, int fq) const {
        const int row0 = u.pm * 256 + wr * 64 + fr;
        if constexpr (MODE == 3) {
            const int col = u.pn * 128 + wc * 32 + 8 * fq;
#pragma unroll
            for (int ai = 0; ai < 2; ++ai)
#pragma unroll
                for (int m = 0; m < 4; ++m) {
                    const int row = row0 + ai * 128 + m * 16;
                    f32x4 v0 = acc[ai][0][m][0], v1 = acc[ai][0][m][1]; const f32x4 g0 = acc[ai][1][m][0], g1 = acc[ai][1][m][1];
#pragma unroll
                    for (int i = 0; i < 4; ++i) { v0[i] *= fsigmoid(g0[i]); v1[i] *= fsigmoid(g1[i]); }
                    u32x4 w; w.x = cvtpk(v0[0], v0[1]); w.y = cvtpk(v0[2], v0[3]); w.z = cvtpk(v1[0], v1[1]); w.w = cvtpk(v1[2], v1[3]);
                    st16_wt(O + (size_t)row * ldc + col, w);
                }
        } else {
#pragma unroll
            for (int ai = 0; ai < 2; ++ai)
#pragma unroll
                for (int m = 0; m < 4; ++m) {
                    const int row = row0 + ai * 128 + m * 16;
#pragma unroll
                    for (int bj = 0; bj < 2; ++bj) {
                        const int col = u.pn * 256 + bj * 128 + wc * 32 + 8 * fq;
                        if (col >= ncols) continue;
                        f32x4 v0 = acc[ai][bj][m][0], v1 = acc[ai][bj][m][1];
                        if constexpr (MODE == 1) {
#pragma unroll
                            for (int i = 0; i < 4; ++i) { v0[i] = fsigmoid(v0[i]); v1[i] = fsigmoid(v1[i]); }
                        }
                        if constexpr (MODE == 2) {
#pragma unroll
                            for (int i = 0; i < 4; ++i) { const float a = fmaxf(v0[i], 0.f), b = fmaxf(v1[i], 0.f); v0[i] = a * a; v1[i] = b * b; }
                        }
                        if constexpr (MODE == 4 || MODE == 5) {
                            const u32x4 gw = *(const u32x4*)(G + (size_t)row * ldg + col);
                            v0[0] *= bflo(gw.x); v0[1] *= bfhi(gw.x); v0[2] *= bflo(gw.y); v0[3] *= bfhi(gw.y);
                            v1[0] *= bflo(gw.z); v1[1] *= bfhi(gw.z); v1[2] *= bflo(gw.w); v1[3] *= bfhi(gw.w);
                            if constexpr (MODE == 5) {
                                const u32x4 ow = *(const u32x4*)(O + (size_t)row * ldc + col);
                                v0[0] += bflo(ow.x); v0[1] += bfhi(ow.x); v0[2] += bflo(ow.y); v0[3] += bfhi(ow.y);
                                v1[0] += bflo(ow.z); v1[1] += bfhi(ow.z); v1[2] += bflo(ow.w); v1[3] += bfhi(ow.w);
                            }
                        }
                        if constexpr (MODE == 6) {
                            if (col >= 512) {
                                const int pos = row & (SEQL - 1);
                                const f32x4 cs0 = *(const f32x4*)(rope + ((size_t)pos * 16 + 4 * fq) * 2), cs1 = *(const f32x4*)(rope + ((size_t)pos * 16 + 4 * fq + 2) * 2);
                                float a, b;
                                a = v0[0]; b = v0[1]; v0[0] = a * cs0[0] - b * cs0[1]; v0[1] = a * cs0[1] + b * cs0[0];
                                a = v0[2]; b = v0[3]; v0[2] = a * cs0[2] - b * cs0[3]; v0[3] = a * cs0[3] + b * cs0[2];
                                a = v1[0]; b = v1[1]; v1[0] = a * cs1[0] - b * cs1[1]; v1[1] = a * cs1[1] + b * cs1[0];
                                a = v1[2]; b = v1[3]; v1[2] = a * cs1[2] - b * cs1[3]; v1[3] = a * cs1[3] + b * cs1[2];
                            }
                        }
                        u32x4 w; w.x = cvtpk(v0[0], v0[1]); w.y = cvtpk(v0[2], v0[3]); w.z = cvtpk(v1[0], v1[1]); w.w = cvtpk(v1[2], v1[3]);
                        if constexpr (MODE == 0 || MODE == 2) st16_wt(O + (size_t)row * ldc + col, w); else *(u32x4*)(O + (size_t)row * ldc + col) = w;
                        if constexpr (MODE == 4 || MODE == 5) asm volatile("" ::: "memory");
                    }
                }
        }
    }
};

template <int MODE>
__device__ __forceinline__ void run_gemm(LAS unsigned char* lds, const bf16_t* A, int lda, const bf16_t* Bt, int ldb, int M, int N, int K, const EpiB<MODE>& E) {
    asm volatile("" : "+s"(K), "+s"(lda), "+s"(ldb), "+s"(N));
    pg8::Gemm g{A, Bt, M, N, K, lda, ldb}; pg8::StaticOrder S; S.init(M, N, (int)gridDim.x, (int)blockIdx.x);
    pg8::gemm_phase<EpiB<MODE>, pg8::StaticOrder, true, true>(lds, g, S, E);
}

__device__ __forceinline__ int wrow_map(int mode, int n) {
    if (mode == 1) { const int hd = n / 96, w = n % 96; return w < 64 ? hd * 64 + w : 512 + hd * 32 + 2 * ((w - 64) & 15) + ((w - 64) >> 4); }
    if (mode == 2) { const int c = n & 511, t = c >> 7; return 256 * t + (n >> 9) * 128 + (c & 127); }
    return n;
}
__device__ __forceinline__ void transpose_item(const float* W, int K, int N, bf16_t* WT, int mode, LAS float* scr, int item, int lane) {
    const int nblk = N / 32, kb = item / nblk, nb = item % nblk, k0 = 64 * kb, n0 = 32 * nb;
#pragma unroll
    for (int i = 0; i < 32; ++i) { const int kk = 2 * i + (lane >> 5); scr[kk * 33 + (lane & 31)] = W[(size_t)(k0 + kk) * N + n0 + (lane & 31)]; }
    asm volatile("s_waitcnt lgkmcnt(0)" ::: "memory");
    const int c = lane & 7;
#pragma unroll
    for (int j = 0; j < 4; ++j) { const int n = (lane >> 3) + 8 * j; const LAS float* s = scr + (8 * c) * 33 + n;
        u32x4 o; o.x = cvtpk(s[0 * 33], s[1 * 33]); o.y = cvtpk(s[2 * 33], s[3 * 33]); o.z = cvtpk(s[4 * 33], s[5 * 33]); o.w = cvtpk(s[6 * 33], s[7 * 33]);
        *(u32x4*)(WT + (size_t)wrow_map(mode, n0 + n) * K + k0 + 8 * c) = o; }
    asm volatile("s_waitcnt lgkmcnt(0)" ::: "memory");
}
__device__ __forceinline__ void convert_weights(PPtr P, int li, LAS unsigned char* lds, int gw, int NGW, int wave, int lane) {
    LAS float* scr = (LAS float*)(lds + wave * 16384);
    bf16_t* Wb = (bf16_t*)(P->ws + OFF_W);
    constexpr int I_IN = 16 * 101, I_GATE = 16 * 128, I_UQ = 4 * 24, I_UKV = 2 * 32, I_GLU = 8 * 32, I_BR = 8 * 32, I_OUT = 16 * 32, I_F1 = 16 * 128, I_F2 = 64 * 32;
    constexpr int NIT = I_IN + I_GATE + I_UQ + I_UKV + I_GLU + 4 * I_BR + I_OUT + I_F1 + I_F2;
    for (int it = gw; it < NIT; it += NGW) {
        int r = it;
        if (r < I_IN) { transpose_item(P->in[5] + (size_t)li * 1024 * 3232, 1024, 3232, Wb + W_IN, 0, scr, r, lane); continue; } r -= I_IN;
        if (r < I_GATE) { transpose_item(P->in[6] + (size_t)li * 1024 * 4096, 1024, 4096, Wb + W_GATE, 0, scr, r, lane); continue; } r -= I_GATE;
        if (r < I_UQ) { transpose_item(P->in[16] + (size_t)li * 256 * 768, 256, 768, Wb + W_UQ, 1, scr, r, lane); continue; } r -= I_UQ;
        if (r < I_UKV) { transpose_item(P->in[17] + (size_t)li * 128 * 1024, 128, 1024, Wb + W_UKV, 0, scr, r, lane); continue; } r -= I_UKV;
        if (r < I_GLU) { transpose_item(P->in[26] + (size_t)li * 512 * 1024, 512, 1024, Wb + W_GLU, 2, scr, r, lane); continue; } r -= I_GLU;
        if (r < 4 * I_BR) { const int b = r / I_BR; transpose_item(P->in[27 + b] + (size_t)li * 512 * 1024, 512, 1024, Wb + W_BR + (size_t)b * 524288, 0, scr, r % I_BR, lane); continue; } r -= 4 * I_BR;
        if (r < I_OUT) { transpose_item(P->in[31] + (size_t)li * 1024 * 1024, 1024, 1024, Wb + W_OUT, 0, scr, r, lane); continue; } r -= I_OUT;
        if (r < I_F1) { transpose_item(P->in[32] + (size_t)li * 1024 * 4096, 1024, 4096, Wb + W_F1, 0, scr, r, lane); continue; } r -= I_F1;
        transpose_item(P->in[33] + (size_t)li * 4096 * 1024, 4096, 1024, Wb + W_F2, 0, scr, r, lane);
    }
    for (int i = gw * 64 + lane; i < 12288; i += NGW * 64) *(u32x4*)(Wb + W_IN + (size_t)3232 * 1024 + (size_t)i * 8) = (u32x4){0u, 0u, 0u, 0u};
}

__device__ __forceinline__ void prenorm_rows(const float* x, const float* g, bf16_t* xn, int gw, int NGW, int lane) {
    for (int row = gw; row < NTOK; row += NGW) {
        const f32x4* xr = (const f32x4*)(x + (size_t)row * DMODEL) + lane; f32x4 v[4]; float ss = 0.f;
#pragma unroll
        for (int j = 0; j < 4; ++j) { v[j] = __builtin_nontemporal_load(xr + 64 * j); ss += (v[j][0] * v[j][0] + v[j][1] * v[j][1]) + (v[j][2] * v[j][2] + v[j][3] * v[j][3]); }
        const float rs = __builtin_amdgcn_rsqf(wave_sum(ss) * (1.f / DMODEL) + EPSN);
        u32x2* o = (u32x2*)(xn + (size_t)row * DMODEL) + lane;
#pragma unroll
        for (int j = 0; j < 4; ++j) { const f32x4 gg = ((const f32x4*)g)[lane + 64 * j]; u32x2 w; w.x = cvtpk(v[j][0] * rs * gg[0], v[j][1] * rs * gg[1]); w.y = cvtpk(v[j][2] * rs * gg[2], v[j][3] * rs * gg[3]); o[64 * j] = w; }
    }
}
__device__ __forceinline__ void resnorm_rows(const float* hin, const bf16_t* tmp, const float* g1, float* hout, const float* g2, bf16_t* xn, int gw, int NGW, int lane) {
    for (int row = gw; row < NTOK; row += NGW) {
        const u32x2* tr = (const u32x2*)(tmp + (size_t)row * DMODEL) + lane; f32x4 t[4]; float ss = 0.f;
#pragma unroll
        for (int j = 0; j < 4; ++j) { const u32x2 w = __builtin_nontemporal_load(tr + 64 * j); t[j] = (f32x4){bflo(w.x), bfhi(w.x), bflo(w.y), bfhi(w.y)}; ss += (t[j][0] * t[j][0] + t[j][1] * t[j][1]) + (t[j][2] * t[j][2] + t[j][3] * t[j][3]); }
        const float rs = __builtin_amdgcn_rsqf(wave_sum(ss) * (1.f / DMODEL) + EPSN);
        const f32x4* hr = (const f32x4*)(hin + (size_t)row * DMODEL) + lane; f32x4* ho = (f32x4*)(hout + (size_t)row * DMODEL) + lane; float s2 = 0.f;
#pragma unroll
        for (int j = 0; j < 4; ++j) { const f32x4 gg = ((const f32x4*)g1)[lane + 64 * j]; f32x4 h = __builtin_nontemporal_load(hr + 64 * j);
            h[0] += t[j][0] * rs * gg[0]; h[1] += t[j][1] * rs * gg[1]; h[2] += t[j][2] * rs * gg[2]; h[3] += t[j][3] * rs * gg[3];
            st16_wt(ho + 64 * j, __builtin_bit_cast(u32x4, h)); t[j] = h; s2 += (h[0] * h[0] + h[1] * h[1]) + (h[2] * h[2] + h[3] * h[3]); }
        if (g2) {
            const float r2 = __builtin_amdgcn_rsqf(wave_sum(s2) * (1.f / DMODEL) + EPSN);
            u32x2* o = (u32x2*)(xn + (size_t)row * DMODEL) + lane;
#pragma unroll
            for (int j = 0; j < 4; ++j) { const f32x4 gg = ((const f32x4*)g2)[lane + 64 * j]; u32x2 w; w.x = cvtpk(t[j][0] * r2 * gg[0], t[j][1] * r2 * gg[1]); w.y = cvtpk(t[j][2] * r2 * gg[2], t[j][3] * r2 * gg[3]); o[64 * j] = w; }
        }
    }
}
__device__ __forceinline__ void prep_rows(bf16_t* proj, const float* gq, const float* gk, const float* mq, const float* mkv, const float* rope, int gw, int NGW, int lane) {
    const int j = lane & 15; const bool up = (lane & 16) != 0;
    for (int row = gw; row < NTOK; row += NGW) {
        bf16_t* pr = proj + (size_t)row * LDP; const int l = row & (SEQL - 1); const int pos = (lane < 32) ? (l >> 6) : (l & 63);
        const f32x2 cs = *(const f32x2*)(rope + ((size_t)pos * 16 + j) * 2);
        float hv[10];
#pragma unroll
        for (int hh = 0; hh < 10; ++hh) hv[hh] = bf1(pr[(hh < 8 ? C_BQ + hh * 64 : C_BK + (hh - 8) * 64) + lane]);
        const float ggq = gq[lane], ggk = gk[lane];
#pragma unroll
        for (int hh = 0; hh < 10; ++hh) {
            const int base = hh < 8 ? C_BQ + hh * 64 : C_BK + (hh - 8) * 64; const float gg = hh < 8 ? ggq : ggk;
            float v = hv[hh]; const float ss = wave_sum(v * v);
            v = v * __builtin_amdgcn_rsqf(ss * (1.f / 64) + EPSN) * gg;
            const float pv = __shfl_xor(v, 16);
            const float o = up ? (pv * cs[1] + v * cs[0]) : (v * cs[0] - pv * cs[1]);
            pr[base + lane] = tobf(o);
        }
        {
            const u32x2 w = *(const u32x2*)(pr + C_CQ + 4 * lane); f32x4 v = {bflo(w.x), bfhi(w.x), bflo(w.y), bfhi(w.y)};
            const float rs = __builtin_amdgcn_rsqf(wave_sum((v[0] * v[0] + v[1] * v[1]) + (v[2] * v[2] + v[3] * v[3])) * (1.f / 256) + EPSN); const f32x4 gg = ((const f32x4*)mq)[lane];
            u32x2 o; o.x = cvtpk(v[0] * rs * gg[0], v[1] * rs * gg[1]); o.y = cvtpk(v[2] * rs * gg[2], v[3] * rs * gg[3]); *(u32x2*)(pr + C_CQ + 4 * lane) = o;
        }
        {
            const unsigned w = *(const unsigned*)(pr + C_CKV + 2 * lane); const float a = bflo(w), b = bfhi(w);
            const float rs = __builtin_amdgcn_rsqf(wave_sum(a * a + b * b) * (1.f / 128) + EPSN); const f32x2 gg = ((const f32x2*)mkv)[lane];
            *(unsigned*)(pr + C_CKV + 2 * lane) = cvtpk(a * rs * gg[0], b * rs * gg[1]);
        }
        {
            const float v = bf1(pr[C_CKR + (lane & 31)]); const float pv = __shfl_xor(v, 16);
            const f32x2 c2 = *(const f32x2*)(rope + ((size_t)l * 16 + j) * 2);
            const float o = up ? (pv * c2[1] + v * c2[0]) : (v * c2[0] - pv * c2[1]);
            if (lane < 32) pr[C_CKR + 2 * j + (lane >> 4)] = tobf(o);
        }
    }
}

struct S5Lane { float lbr, lbi; f32x2 bb[16]; };
__device__ __forceinline__ void s5_setup(PPtr P, int li, int dir, int g, int p, S5Lane& L) {
    const size_t ga = ((size_t)(li * 2 + dir) * 32 + g);
    const float are = fminf(P->in[18][ga * 64 + p], -1e-4f), aim = P->in[19][ga * 64 + p]; const float dt = expf(P->in[20][ga]);
    const float mag = expf(are * dt); float sn, cn; sincos_d((double)(aim * dt), sn, cn);
    L.lbr = mag * cn; L.lbi = mag * sn;
    const float den = are * are + aim * aim, nre = L.lbr - 1.f;
    const float fre = (nre * are + L.lbi * aim) / den, fim = (L.lbi * are - nre * aim) / den;
    const f32x4* br = (const f32x4*)(P->in[21] + (ga * 64 + p) * 16); const f32x4* bi = (const f32x4*)(P->in[22] + (ga * 64 + p) * 16);
#pragma unroll
    for (int q = 0; q < 4; ++q) { const f32x4 r = br[q], i = bi[q];
#pragma unroll
        for (int e = 0; e < 4; ++e) L.bb[4 * q + e] = (f32x2){fre * r[e] - fim * i[e], fre * i[e] + fim * r[e]}; }
}
__device__ __forceinline__ void s5_step(const S5Lane& L, const LAS unsigned char* urow, float& sr, float& si) {
    const u32x4 ua = *(const LAS u32x4*)urow, ub = *(const LAS u32x4*)(urow + 16);
    f32x2 x2;
#define S5_U2(v) ((f32x2){(v), (v)})
    x2 = S5_U2(bflo(ua.x)) * L.bb[0];
    x2 = __builtin_elementwise_fma(S5_U2(bfhi(ua.x)), L.bb[1], x2);
    x2 = __builtin_elementwise_fma(S5_U2(bflo(ua.y)), L.bb[2], x2);
    x2 = __builtin_elementwise_fma(S5_U2(bfhi(ua.y)), L.bb[3], x2);
    x2 = __builtin_elementwise_fma(S5_U2(bflo(ua.z)), L.bb[4], x2);
    x2 = __builtin_elementwise_fma(S5_U2(bfhi(ua.z)), L.bb[5], x2);
    x2 = __builtin_elementwise_fma(S5_U2(bflo(ua.w)), L.bb[6], x2);
    x2 = __builtin_elementwise_fma(S5_U2(bfhi(ua.w)), L.bb[7], x2);
    x2 = __builtin_elementwise_fma(S5_U2(bflo(ub.x)), L.bb[8], x2);
    x2 = __builtin_elementwise_fma(S5_U2(bfhi(ub.x)), L.bb[9], x2);
    x2 = __builtin_elementwise_fma(S5_U2(bflo(ub.y)), L.bb[10], x2);
    x2 = __builtin_elementwise_fma(S5_U2(bfhi(ub.y)), L.bb[11], x2);
    x2 = __builtin_elementwise_fma(S5_U2(bflo(ub.z)), L.bb[12], x2);
    x2 = __builtin_elementwise_fma(S5_U2(bfhi(ub.z)), L.bb[13], x2);
    x2 = __builtin_elementwise_fma(S5_U2(bflo(ub.w)), L.bb[14], x2);
    x2 = __builtin_elementwise_fma(S5_U2(bfhi(ub.w)), L.bb[15], x2);
#undef S5_U2
    const float xr = x2[0], xi = x2[1];
    const float nr = L.lbr * sr - L.lbi * si + xr, ni = L.lbr * si + L.lbi * sr + xi; sr = nr; si = ni;
}
__device__ __forceinline__ void s5_stage_u(const bf16_t* proj, int b, int g, int ch, LAS unsigned char* ulds, int lane) {
    const bf16_t* src = proj + ((size_t)b * SEQL + (size_t)ch * S5_CH) * LDP + C_DU + g * 16;
#pragma unroll
    for (int it = 0; it < 4; ++it) { const int r = it * 32 + (lane >> 1), hf = lane & 1; *(LAS u32x4*)(ulds + r * 32 + hf * 16) = *(const u32x4*)(src + (size_t)r * LDP + hf * 8); }
    asm volatile("s_waitcnt vmcnt(0) lgkmcnt(0)" ::: "memory");
}
__device__ __forceinline__ void s5_pass1(PPtr P, int li, LAS unsigned char* lds, int gw, int NGW, int wave, int lane) {
    LAS unsigned char* ulds = lds + wave * 16640; const bf16_t* proj = (const bf16_t*)(P->ws + OFF_PROJ); f32x2* carry = (f32x2*)(P->ws + OFF_CARRY);
    for (int item = gw; item < NBATCH * 32 * S5_NCH; item += NGW) {
        const int ch = item % S5_NCH, g = (item / S5_NCH) % 32, b = item / (S5_NCH * 32);
        s5_stage_u(proj, b, g, ch, ulds, lane);
#pragma unroll 1
        for (int dir = 0; dir < 2; ++dir) {
            S5Lane L; s5_setup(P, li, dir, g, lane, L); float sr = 0.f, si = 0.f;
#pragma unroll 2
            for (int jj = 0; jj < S5_CH; ++jj) { const int j = dir ? S5_CH - 1 - jj : jj; s5_step(L, ulds + j * 32, sr, si); }
            carry[((((size_t)b * 32 + g) * S5_NCH + ch) * 2 + dir) * 64 + lane] = (f32x2){sr, si};
        }
        asm volatile("s_waitcnt lgkmcnt(0)" ::: "memory");
    }
}
__device__ __forceinline__ void s5_pass2(PPtr P, int li, LAS unsigned char* lds, int gw, int NGW, int wave, int lane) {
    LAS unsigned char* ulds = lds + wave * 16640; LAS unsigned char* slds = ulds + 4096; LAS float* ylds = (LAS float*)(ulds + 4096 + 4352);
    bf16_t* proj = (bf16_t*)(P->ws + OFF_PROJ); const f32x2* carry = (const f32x2*)(P->ws + OFF_CARRY);
    const int hq = lane & 15, kq = lane >> 4;
    for (int item = gw; item < NBATCH * 32 * S5_NCH; item += NGW) {
        const int ch = item % S5_NCH, g = (item / S5_NCH) % 32, b = item / (S5_NCH * 32);
        s5_stage_u(proj, b, g, ch, ulds, lane);
#pragma unroll 1
        for (int dir = 0; dir < 2; ++dir) {
            S5Lane L; s5_setup(P, li, dir, g, lane, L);
            float cr = L.lbr, ci = L.lbi;
#pragma unroll
            for (int q = 0; q < 7; ++q) { const float nr = cr * cr - ci * ci, ni = 2.f * cr * ci; cr = nr; ci = ni; }
            float sr = 0.f, si = 0.f;
            const f32x2* cb = carry + ((((size_t)b * 32 + g) * S5_NCH) * 2 + dir) * 64 + lane;
            if (dir == 0) {
#pragma unroll 4
                for (int c = 0; c < ch; ++c) { const f32x2 e = cb[(size_t)c * 128]; const float nr = cr * sr - ci * si + e[0], ni = cr * si + ci * sr + e[1]; sr = nr; si = ni; } }
            else {
#pragma unroll 4
                for (int c = S5_NCH - 1; c > ch; --c) { const f32x2 e = cb[(size_t)c * 128]; const float nr = cr * sr - ci * si + e[0], ni = cr * si + ci * sr + e[1]; sr = nr; si = ni; } }
            bf16x8 bc[4];
            { const size_t cbase = (((size_t)(li * 2 + dir) * 32 + g) * 16 + hq) * 64;
#pragma unroll
              for (int ks = 0; ks < 4; ++ks) { const f32x4 re = *(const f32x4*)(P->in[23] + cbase + 16 * ks + 4 * kq), im = *(const f32x4*)(P->in[24] + cbase + 16 * ks + 4 * kq);
                  u32x4 w; w.x = cvtpk(re[0], -im[0]); w.y = cvtpk(re[1], -im[1]); w.z = cvtpk(re[2], -im[2]); w.w = cvtpk(re[3], -im[3]); bc[ks] = __builtin_bit_cast(bf16x8, w); } }
#pragma unroll 1
            for (int sb = 0; sb < S5_CH / 16; ++sb) {
                const int sub = dir ? S5_CH / 16 - 1 - sb : sb;
#pragma unroll 2
                for (int q = 0; q < 16; ++q) { const int jj = dir ? 15 - q : q; s5_step(L, ulds + (sub * 16 + jj) * 32, sr, si); *(LAS unsigned*)(slds + jj * 272 + lane * 4) = cvtpk(sr, si); }
                asm volatile("s_waitcnt lgkmcnt(0)" ::: "memory");
                f32x4 acc = {0.f, 0.f, 0.f, 0.f};
#pragma unroll
                for (int ks = 0; ks < 4; ++ks) { const bf16x8 a = *(const LAS bf16x8*)(slds + hq * 272 + ks * 64 + kq * 16); acc = __builtin_amdgcn_mfma_f32_16x16x32_bf16(a, bc[ks], acc, 0, 0, 0); }
                asm volatile("s_nop 15\n\ts_nop 15" : "+v"(acc));
                LAS float* yp = ylds + (sub * 16 + kq * 4) * 16 + hq;
                if (dir == 0) { yp[0] = acc[0]; yp[16] = acc[1]; yp[32] = acc[2]; yp[48] = acc[3]; }
                else { yp[0] += acc[0]; yp[16] += acc[1]; yp[32] += acc[2]; yp[48] += acc[3]; }
                asm volatile("s_waitcnt lgkmcnt(0)" ::: "memory");
            }
        }
        const float dd = P->in[25][((size_t)li * 32 + g) * 16 + hq];
        bf16_t* dst = proj + ((size_t)b * SEQL + (size_t)ch * S5_CH) * LDP + C_DU + g * 16 + hq;
#pragma unroll 4
        for (int it = 0; it < S5_CH / 4; ++it) { const int r = it * 4 + kq; const float uu = bf1(*(const LAS bf16_t*)(ulds + r * 32 + hq * 2)); const float y = ylds[r * 16 + hq] + dd * uu;
            const float z = 1.5957691216057308f * (y + 0.044715f * y * y * y); dst[(size_t)r * LDP] = tobf(y * fsigmoid(z)); }
        asm volatile("s_waitcnt lgkmcnt(0)" ::: "memory");
    }
}

constexpr int S5_XP = 132;
constexpr int S5_WLDS = 4096 + 16 * S5_XP * 4 + 16 * 272;
template <int DIR, bool PASS2>
__device__ __forceinline__ void s5_sub(LAS unsigned char* ulds, const bf16x8 (&bb)[8], const bf16x8 (&bc)[4], float lbr, float lbi, float& sr, float& si, f32x4& yacc, int sub, int lane) {
    LAS float* xlds = (LAS float*)(ulds + 4096); LAS unsigned char* slds = ulds + 4096 + 16 * S5_XP * 4;
    const int hq = lane & 15, kq = lane >> 4;
    u32x4 uw = {0u, 0u, 0u, 0u};
    if (kq < 2) uw = *(const LAS u32x4*)(ulds + (sub * 16 + hq) * 32 + kq * 16);
    const bf16x8 ua = __builtin_bit_cast(bf16x8, uw);
    LAS float* xp = xlds + (4 * kq) * S5_XP + hq;
    f32x4 xs[8];
#pragma unroll
    for (int nt = 0; nt < 8; ++nt) xs[nt] = __builtin_amdgcn_mfma_f32_16x16x32_bf16(ua, bb[nt], (f32x4){0.f, 0.f, 0.f, 0.f}, 0, 0, 0);
    asm volatile("s_nop 15\n\ts_nop 15" : "+v"(xs[0]), "+v"(xs[1]), "+v"(xs[2]), "+v"(xs[3]), "+v"(xs[4]), "+v"(xs[5]), "+v"(xs[6]), "+v"(xs[7]));
#pragma unroll
    for (int nt = 0; nt < 8; ++nt) { xp[16 * nt] = xs[nt][0]; xp[16 * nt + S5_XP] = xs[nt][1]; xp[16 * nt + 2 * S5_XP] = xs[nt][2]; xp[16 * nt + 3 * S5_XP] = xs[nt][3]; }
    asm volatile("s_waitcnt lgkmcnt(0)" ::: "memory");
    const LAS float* xr = xlds + 2 * lane; LAS unsigned char* sw = slds + lane * 4;
#pragma unroll
    for (int q = 0; q < 16; ++q) {
        const int jj = DIR ? 15 - q : q;
        const f32x2 x = *(const LAS f32x2*)(xr + jj * S5_XP);
        const float nr = lbr * sr - lbi * si + x[0], ni = lbr * si + lbi * sr + x[1]; sr = nr; si = ni;
        if (PASS2) *(LAS unsigned*)(sw + jj * 272) = cvtpk(sr, si);
    }
    if (PASS2) {
        asm volatile("s_waitcnt lgkmcnt(0)" ::: "memory");
        f32x4 acc = DIR ? yacc : (f32x4){0.f, 0.f, 0.f, 0.f};
        const LAS unsigned char* sa = slds + hq * 272 + kq * 16;
#pragma unroll
        for (int ks = 0; ks < 4; ++ks) { const bf16x8 a = *(const LAS bf16x8*)(sa + ks * 64); acc = __builtin_amdgcn_mfma_f32_16x16x32_bf16(a, bc[ks], acc, 0, 0, 0); }
        yacc = acc;
    }
    asm volatile("s_waitcnt lgkmcnt(0)" ::: "memory");
    __builtin_amdgcn_sched_barrier(0);
}
template <int DIR, bool PASS2>
__device__ __forceinline__ void s5_dir(LAS unsigned char* ulds, const bf16x8 (&bb)[8], const bf16x8 (&bc)[4], float lbr, float lbi, float& sr, float& si, f32x4 (&yacc)[8], int lane) {
    if constexpr (PASS2) {
#pragma unroll
        for (int sb = 0; sb < 8; ++sb) { const int sub = DIR ? 7 - sb : sb; s5_sub<DIR, true>(ulds, bb, bc, lbr, lbi, sr, si, yacc[sub], sub, lane); }
    } else {
#pragma unroll 1
        for (int sb = 0; sb < 8; ++sb) { const int sub = DIR ? 7 - sb : sb; s5_sub<DIR, false>(ulds, bb, bc, lbr, lbi, sr, si, yacc[0], sub, lane); }
    }
}

__device__ __forceinline__ void s5n_setup(PPtr P, int li, int dir, int g, int lane, float& lbr, float& lbi, bf16x8 (&bb)[8], LAS unsigned char* scr) {
    const size_t ga = ((size_t)(li * 2 + dir) * 32 + g);
    const float are = fminf(P->in[18][ga * 64 + lane], -1e-4f), aim = P->in[19][ga * 64 + lane]; const float dt = expf(P->in[20][ga]);
    const float mag = expf(are * dt); float sn, cn;
    { float xr_ = aim * dt * 0.15915494309189535f; xr_ -= __builtin_rintf(xr_); sn = __builtin_amdgcn_sinf(xr_); cn = __builtin_amdgcn_cosf(xr_); }
    lbr = mag * cn; lbi = mag * sn; const float den = are * are + aim * aim, nre = lbr - 1.f;
    const float fre = (nre * are + lbi * aim) / den, fim = (lbi * are - nre * aim) / den;
    const int hq = lane & 15, kq = lane >> 4, ri = lane & 1;
#pragma unroll 1
    for (int nt = 0; nt < 8; ++nt) {
        const int pp = 8 * nt + (hq >> 1); const float fr2 = __shfl(fre, pp), fi2 = __shfl(fim, pp);
        const int kq2 = kq & 1;
        const f32x4* br = (const f32x4*)(P->in[21] + (ga * 64 + pp) * 16 + 8 * kq2); const f32x4* bi = (const f32x4*)(P->in[22] + (ga * 64 + pp) * 16 + 8 * kq2);
        const f32x4 r0 = br[0], r1 = br[1], i0 = bi[0], i1 = bi[1]; float v[8];
#pragma unroll
        for (int e = 0; e < 4; ++e) { v[e] = ri ? (fr2 * i0[e] + fi2 * r0[e]) : (fr2 * r0[e] - fi2 * i0[e]); v[4 + e] = ri ? (fr2 * i1[e] + fi2 * r1[e]) : (fr2 * r1[e] - fi2 * i1[e]); }
        u32x4 w; w.x = cvtpk(v[0], v[1]); w.y = cvtpk(v[2], v[3]); w.z = cvtpk(v[4], v[5]); w.w = cvtpk(v[6], v[7]);
        if (kq >= 2) w = (u32x4){0u, 0u, 0u, 0u};
        *(LAS u32x4*)(scr + (nt * 64 + lane) * 16) = w;
    }
    asm volatile("s_waitcnt lgkmcnt(0)" ::: "memory");
#pragma unroll
    for (int nt = 0; nt < 8; ++nt) bb[nt] = *(const LAS bf16x8*)(scr + (nt * 64 + lane) * 16);
    asm volatile("s_waitcnt lgkmcnt(0)" ::: "memory");
}
__device__ __forceinline__ void s5n_stage_u(const bf16_t* proj, int b, int g, int ch, LAS unsigned char* ulds, int lane) {
    const bf16_t* src = proj + ((size_t)b * SEQL + (size_t)ch * S5_CH) * LDP + C_DU + g * 16;
#pragma unroll
    for (int it = 0; it < 4; ++it) { const int r = it * 32 + (lane >> 1), hf = lane & 1; *(LAS u32x4*)(ulds + r * 32 + hf * 16) = *(const u32x4*)(src + (size_t)r * LDP + hf * 8); }
    asm volatile("s_waitcnt vmcnt(0) lgkmcnt(0)" ::: "memory");
}
__device__ __forceinline__ void s5n_pass1(PPtr P, int li, LAS unsigned char* lds, int gw, int NGW, int wave, int lane) {
    LAS unsigned char* ulds = lds + wave * S5_WLDS; const bf16_t* proj = (const bf16_t*)(P->ws + OFF_PROJ); f32x2* carry = (f32x2*)(P->ws + OFF_CARRY);
    for (int item = gw; item < NBATCH * 32 * S5_NCH; item += NGW) {
        const int ch = item % S5_NCH, g = (item / S5_NCH) % 32, b = item / (S5_NCH * 32);
        s5n_stage_u(proj, b, g, ch, ulds, lane);
#pragma unroll 1
        for (int dir = 0; dir < 2; ++dir) {
            float lbr, lbi; bf16x8 bb[8], bc[4]; f32x4 ydummy[8];
            s5n_setup(P, li, dir, g, lane, lbr, lbi, bb, ulds + 4096);
            float sr = 0.f, si = 0.f;
            if (dir == 0) s5_dir<0, false>(ulds, bb, bc, lbr, lbi, sr, si, ydummy, lane); else s5_dir<1, false>(ulds, bb, bc, lbr, lbi, sr, si, ydummy, lane);
            carry[((((size_t)b * 32 + g) * S5_NCH + ch) * 2 + dir) * 64 + lane] = (f32x2){sr, si};
        }
    }
}

template <int DIR> __device__ __forceinline__ void s5_carry_in(const f32x2* cb, int ch, float lbr, float lbi, float& sr, float& si) {
    float cr = lbr, ci = lbi;
#pragma unroll
    for (int q = 0; q < 7; ++q) { const float nr = cr * cr - ci * ci, ni = 2.f * cr * ci; cr = nr; ci = ni; }
    sr = 0.f; si = 0.f;
    if (DIR == 0) {
#pragma unroll 4
        for (int c = 0; c < ch; ++c) { const f32x2 e = cb[(size_t)c * 128]; const float nr = cr * sr - ci * si + e[0], ni = cr * si + ci * sr + e[1]; sr = nr; si = ni; }
    } else {
#pragma unroll 4
        for (int c = S5_NCH - 1; c > ch; --c) { const f32x2 e = cb[(size_t)c * 128]; const float nr = cr * sr - ci * si + e[0], ni = cr * si + ci * sr + e[1]; sr = nr; si = ni; }
    }
}
__device__ __forceinline__ void s5h_pass2(PPtr P, int li, LAS unsigned char* lds, int gw, int NGW, int wave, int lane) {
    LAS unsigned char* ulds = lds + wave * S5_WLDS; bf16_t* proj = (bf16_t*)(P->ws + OFF_PROJ); const f32x2* carry = (const f32x2*)(P->ws + OFF_CARRY);
    const int hq = lane & 15, kq = lane >> 4;
    for (int item = gw; item < NBATCH * 32 * S5_NCH; item += NGW) {
        const int ch = item % S5_NCH, g = (item / S5_NCH) % 32, b = item / (S5_NCH * 32);
        s5n_stage_u(proj, b, g, ch, ulds, lane);
        bf16_t* dst = proj + ((size_t)b * SEQL + (size_t)ch * S5_CH) * LDP + C_DU + g * 16 + hq;
        const float dd = P->in[25][((size_t)li * 32 + g) * 16 + hq];
#pragma unroll 1
        for (int dir = 0; dir < 2; ++dir) {
            float lbr, lbi; bf16x8 bb[8], bc[4];
            s5n_setup(P, li, dir, g, lane, lbr, lbi, bb, ulds + 4096);
            { const size_t cbase = (((size_t)(li * 2 + dir) * 32 + g) * 16 + hq) * 64;
#pragma unroll
              for (int ks = 0; ks < 4; ++ks) { const f32x4 re = *(const f32x4*)(P->in[23] + cbase + 16 * ks + 4 * kq), im = *(const f32x4*)(P->in[24] + cbase + 16 * ks + 4 * kq);
                  u32x4 w; w.x = cvtpk(re[0], -im[0]); w.y = cvtpk(re[1], -im[1]); w.z = cvtpk(re[2], -im[2]); w.w = cvtpk(re[3], -im[3]); bc[ks] = __builtin_bit_cast(bf16x8, w); } }
            float sr, si;
            const f32x2* cb = carry + ((((size_t)b * 32 + g) * S5_NCH) * 2 + dir) * 64 + lane;
            if (dir == 0) s5_carry_in<0>(cb, ch, lbr, lbi, sr, si); else s5_carry_in<1>(cb, ch, lbr, lbi, sr, si);
#pragma unroll 1
            for (int sb = 0; sb < 8; ++sb) {
                const int sub = dir ? 7 - sb : sb;
                bf16_t* drow = dst + (size_t)(sub * 16 + 4 * kq) * LDP;
                float yf[4] = {0.f, 0.f, 0.f, 0.f};
                if (dir) {
#pragma unroll
                    for (int i = 0; i < 4; ++i) yf[i] = bf1(drow[(size_t)i * LDP]);
                }
                f32x4 acc = {0.f, 0.f, 0.f, 0.f};
                if (dir == 0) s5_sub<0, true>(ulds, bb, bc, lbr, lbi, sr, si, acc, sub, lane); else s5_sub<1, true>(ulds, bb, bc, lbr, lbi, sr, si, acc, sub, lane);
                if (dir == 0) {
#pragma unroll
                    for (int i = 0; i < 4; ++i) drow[(size_t)i * LDP] = tobf(acc[i]);
                } else {
#pragma unroll
                    for (int i = 0; i < 4; ++i) { const int r = sub * 16 + 4 * kq + i; const float uu = bf1(*(const LAS bf16_t*)(ulds + r * 32 + hq * 2)); const float y = acc[i] + yf[i] + dd * uu;
                        const float z = 1.5957691216057308f * (y + 0.044715f * y * y * y); drow[(size_t)i * LDP] = tobf(y * fsigmoid(z)); }
                }
            }
        }
        asm volatile("s_waitcnt vmcnt(0) lgkmcnt(0)" ::: "memory");
    }
}

typedef short v4i16_t __attribute__((ext_vector_type(4)));
__device__ __forceinline__ float other_half(float v) { unsigned a = __builtin_bit_cast(unsigned, v), b = a; asm volatile("" : "+v"(b)); auto rr = __builtin_amdgcn_permlane32_swap(a, b, false, false);
    const float x = __builtin_bit_cast(float, rr[0]), y = __builtin_bit_cast(float, rr[1]); return (threadIdx.x & 32) ? x : y; }
__device__ __forceinline__ float max3f(float a, float b, float c) { float r; asm("v_max3_f32 %0, %1, %2, %3" : "=v"(r) : "v"(a), "v"(b), "v"(c)); return r; }
__device__ __forceinline__ bf16x8 scale_frag(bf16x8 f, float c) { const u32x4 w = __builtin_bit_cast(u32x4, f); u32x4 o;
    o.x = cvtpk(bflo(w.x) * c, bfhi(w.x) * c); o.y = cvtpk(bflo(w.y) * c, bfhi(w.y) * c); o.z = cvtpk(bflo(w.z) * c, bfhi(w.z) * c); o.w = cvtpk(bflo(w.w) * c, bfhi(w.w) * c); return __builtin_bit_cast(bf16x8, o); }
template <int DQK, int DV, bool BIAS>
__device__ __forceinline__ void attn_pass(LAS unsigned char* lds, const bf16_t* Qw, int ldq, const bf16_t* Q2w, int ldq2, const bf16_t* Kg, int ldk, const bf16_t* K2g, int ldk2,
                                          const bf16_t* Vg, int ldv, int qpos0, float cs, float sl2, const float* ropetab, f32x16 (&o)[DV / 32]) {
    constexpr int KP = DQK * 2 + 16, KBUF = 64 * KP, VBUF = (DV / 32) * 4096, NKS = DQK / 16, NDT = DV / 32, NVL = DV / 64, VOFF = ((DV == 64) ? 4 : 2) * KBUF;
    int tid_ = threadIdx.x; asm volatile("" : "+v"(tid_));
    const int tid = tid_, lane = tid & 63, r32 = lane & 31, hi = lane >> 5;
    const bool isY = false;
    bf16x8 qf[NKS];
#pragma unroll
    for (int ks = 0; ks < NKS; ++ks) qf[ks] = ks < 4 ? *(const bf16x8*)(Qw + (size_t)r32 * ldq + ks * 16 + hi * 8) : *(const bf16x8*)(Q2w + (size_t)r32 * ldq2 + (ks - 4) * 16 + hi * 8);
#pragma unroll
    for (int ks = 0; ks < 4; ++ks) qf[ks] = scale_frag(qf[ks], cs);
    if constexpr (DQK == 96) {
        const float* rp = ropetab + ((size_t)(qpos0 + r32) * 16) * 2;
#pragma unroll
        for (int ks = 4; ks < 6; ++ks) {
            const f32x4 c0 = *(const f32x4*)(rp + ((ks - 4) * 8 + hi * 4) * 2), c1 = *(const f32x4*)(rp + ((ks - 4) * 8 + hi * 4 + 2) * 2);
            const u32x4 w = __builtin_bit_cast(u32x4, qf[ks]); u32x4 ow;
            { const float a = bflo(w.x) * cs, b = bfhi(w.x) * cs; ow.x = cvtpk(a * c0[0] - b * c0[1], a * c0[1] + b * c0[0]); }
            { const float a = bflo(w.y) * cs, b = bfhi(w.y) * cs; ow.y = cvtpk(a * c0[2] - b * c0[3], a * c0[3] + b * c0[2]); }
            { const float a = bflo(w.z) * cs, b = bfhi(w.z) * cs; ow.z = cvtpk(a * c1[0] - b * c1[1], a * c1[1] + b * c1[0]); }
            { const float a = bflo(w.w) * cs, b = bfhi(w.w) * cs; ow.w = cvtpk(a * c1[2] - b * c1[3], a * c1[3] + b * c1[2]); }
            qf[ks] = __builtin_bit_cast(bf16x8, ow);
        }
    }
#pragma unroll
    for (int d = 0; d < NDT; ++d)
#pragma unroll
        for (int r = 0; r < 16; ++r) o[d][r] = 0.f;
#pragma unroll
    for (int ks = 0; ks < NKS; ++ks) asm volatile("" : "+v"(qf[ks]));
    float mhat = 0.f, l = 0.f; f32x16 negm;
#pragma unroll
    for (int r = 0; r < 16; ++r) negm[r] = 0.f;
    constexpr int TPB = (DV == 64) ? 2 : 1, NG = SEQL / 64 / TPB;
    u32x4 kreg[TPB], k2reg[TPB], vreg[TPB][NVL];
    const bf16_t* kptr = Kg + (size_t)(tid >> 3) * ldk + (tid & 7) * 8;
    const bf16_t* k2ptr = (DQK == 96) ? K2g + (size_t)(tid >> 2) * ldk2 + (tid & 3) * 8 : nullptr;
#define ATT_LOAD(t, j_) do { kreg[j_] = *(const u32x4*)(kptr + (size_t)(t) * 64 * ldk); \
        if (DQK == 96) { if (tid < 256) k2reg[j_] = *(const u32x4*)(k2ptr + (size_t)(t) * 64 * ldk2); } \
        _Pragma("unroll") for (int i_ = 0; i_ < NVL; ++i_) { const int idx_ = tid + 512 * i_; vreg[j_][i_] = *(const u32x4*)(Vg + (size_t)((t) * 64 + ((idx_ & 255) >> 2)) * ldv + (idx_ >> 8) * 32 + (idx_ & 3) * 8); } } while (0)
#define ATT_STORE(sl_, j_) do { *(LAS u32x4*)(lds + (sl_) * KBUF + (tid >> 3) * KP + (tid & 7) * 16) = kreg[j_]; \
        if (DQK == 96) { if (tid < 256) *(LAS u32x4*)(lds + (sl_) * KBUF + (tid >> 2) * KP + 128 + (tid & 3) * 16) = k2reg[j_]; } \
        _Pragma("unroll") for (int i_ = 0; i_ < NVL; ++i_) { const int idx_ = tid + 512 * i_; *(LAS u32x4*)(lds + VOFF + (sl_) * VBUF + (idx_ >> 8) * 4096 + ((idx_ & 255) >> 2) * 64 + (idx_ & 3) * 16) = vreg[j_][i_]; } } while (0)
    u32x4 pw[4];
#pragma unroll
    for (int j = 0; j < TPB; ++j) { ATT_LOAD(j, j); ATT_STORE(j, j); }
#pragma unroll
    for (int j = 0; j < TPB; ++j) ATT_LOAD(TPB + j, j);
    const float qp = (float)(qpos0 + r32);
#pragma unroll 2
    for (int g = 0; g < NG; ++g) {
        const int pair = g & 1;
        __syncthreads();
        if (g + 1 < NG) {
#pragma unroll
            for (int j = 0; j < TPB; ++j) ATT_STORE((pair ^ 1) * TPB + j, j);
            if (g + 2 < NG) {
#pragma unroll
                for (int j = 0; j < TPB; ++j) ATT_LOAD((g + 2) * TPB + j, j);
            }
        }
#pragma unroll
      for (int sub = 0; sub < TPB; ++sub) {
        const int t = g * TPB + sub, buf = pair * TPB + sub, vcur = buf;
        f32x16 p0, p1;
        const LAS unsigned char* kb = lds + buf * KBUF + r32 * KP + hi * 16;
#pragma unroll
        for (int ks = 0; ks < NKS; ++ks) {
            const bf16x8 k0 = *(const LAS bf16x8*)(kb + ks * 32), k1 = *(const LAS bf16x8*)(kb + 32 * KP + ks * 32);
            if (ks == 0) { p0 = __builtin_amdgcn_mfma_f32_32x32x16_bf16(k0, qf[0], negm, 0, 0, 0); p1 = __builtin_amdgcn_mfma_f32_32x32x16_bf16(k1, qf[0], negm, 0, 0, 0); }
            else { p0 = __builtin_amdgcn_mfma_f32_32x32x16_bf16(k0, qf[ks], p0, 0, 0, 0); p1 = __builtin_amdgcn_mfma_f32_32x32x16_bf16(k1, qf[ks], p1, 0, 0, 0); }
        }
        if (BIAS) {
            asm volatile("s_nop 15\n\ts_nop 7" : "+v"(p0), "+v"(p1));
            const float d0 = qp - (float)(t * 64 + 4 * hi);
#pragma unroll
            for (int r = 0; r < 16; ++r) { const float dk = d0 - (float)((r & 3) + 8 * (r >> 2)); p0[r] = p0[r] - sl2 * fabsf(dk); p1[r] = p1[r] - sl2 * fabsf(dk - 32.f); }
        } else {
            asm volatile("s_nop 15\n\ts_nop 7" : "+v"(p0), "+v"(p1));
        }
        float mxa = max3f(p0[0], p0[1], p1[0]), mxb = max3f(p0[2], p0[3], p1[1]); mxa = max3f(mxa, p1[2], p1[3]);
#pragma unroll
        for (int r = 4; r < 16; r += 4) { mxa = max3f(mxa, p0[r], p0[r + 1]); mxb = max3f(mxb, p0[r + 2], p0[r + 3]); mxa = max3f(mxa, p1[r], p1[r + 1]); mxb = max3f(mxb, p1[r + 2], p1[r + 3]); }
        float mx = fmaxf(mxa, mxb);
        if (__any(mx > 8.f)) {
            mx = fmaxf(mx, __shfl_xor(mx, 32));
            const float dl = fmaxf(mx, 0.f); mhat += dl;
            const float f = __builtin_amdgcn_exp2f(-dl);
#pragma unroll
            for (int r = 0; r < 16; ++r) { p0[r] -= dl; p1[r] -= dl; negm[r] = -mhat; }
            l *= f;
#pragma unroll
            for (int d = 0; d < NDT; ++d)
#pragma unroll
                for (int r = 0; r < 16; ++r) o[d][r] *= f;
        }
        if (!isY) {
            const LAS unsigned char* vbase = lds + VOFF + vcur * VBUF + (4 * hi + ((lane & 15) >> 2)) * 64 + ((lane >> 4) & 1) * 32 + (lane & 3) * 8;
            float ls = 0.f;
#pragma unroll
            for (int hs = 0; hs < 4; ++hs) {
                float e[8];
#pragma unroll
                for (int j = 0; j < 8; ++j) { e[j] = __builtin_amdgcn_exp2f(hs < 2 ? p0[8 * (hs & 1) + j] : p1[8 * (hs & 1) + j]); ls += e[j]; }
                pw[hs].x = cvtpk(e[0], e[1]); pw[hs].y = cvtpk(e[2], e[3]); pw[hs].z = cvtpk(e[4], e[5]); pw[hs].w = cvtpk(e[6], e[7]);
                const bf16x8 pbv = __builtin_bit_cast(bf16x8, pw[hs]);
#pragma unroll
                for (int d = 0; d < NDT; ++d) { const LAS unsigned char* vp = vbase + d * 4096 + hs * 1024;
                    const v4i16_t a0 = __builtin_amdgcn_ds_read_tr16_b64_v4i16((LAS v4i16_t*)vp), a1 = __builtin_amdgcn_ds_read_tr16_b64_v4i16((LAS v4i16_t*)(vp + 512));
                    const bf16x8 av = {a0[0], a0[1], a0[2], a0[3], a1[0], a1[1], a1[2], a1[3]};
                    o[d] = __builtin_amdgcn_mfma_f32_32x32x16_bf16(av, pbv, o[d], 0, 0, 0); }
                __builtin_amdgcn_sched_barrier(0);
            }
            l += ls;
        } else {
            float ls = 0.f;
#pragma unroll
            for (int r = 0; r < 16; ++r) { p0[r] = __builtin_amdgcn_exp2f(p0[r]); p1[r] = __builtin_amdgcn_exp2f(p1[r]); ls += p0[r] + p1[r]; }
            l += ls;
#pragma unroll
            for (int s = 0; s < 2; ++s) {
                pw[s].x = cvtpk(p0[8 * s + 0], p0[8 * s + 1]); pw[s].y = cvtpk(p0[8 * s + 2], p0[8 * s + 3]); pw[s].z = cvtpk(p0[8 * s + 4], p0[8 * s + 5]); pw[s].w = cvtpk(p0[8 * s + 6], p0[8 * s + 7]);
                pw[2 + s].x = cvtpk(p1[8 * s + 0], p1[8 * s + 1]); pw[2 + s].y = cvtpk(p1[8 * s + 2], p1[8 * s + 3]); pw[2 + s].z = cvtpk(p1[8 * s + 4], p1[8 * s + 5]); pw[2 + s].w = cvtpk(p1[8 * s + 6], p1[8 * s + 7]);
            }
        }
      }
    }
    __syncthreads();
#undef ATT_LOAD
#undef ATT_STORE
#undef ATT_PV
    l += __shfl_xor(l, 32);
    const float inv = 1.f / l;
#pragma unroll
    for (int d = 0; d < NDT; ++d)
#pragma unroll
        for (int r = 0; r < 16; ++r) o[d][r] *= inv;
}
template <int NDT> __device__ __forceinline__ void attn_store(const f32x16 (&o)[NDT], bf16_t* Ow, int ldo, int r32, int hi) {
#pragma unroll
    for (int d = 0; d < NDT; ++d)
#pragma unroll
        for (int q = 0; q < 4; ++q) { u32x2 w; w.x = cvtpk(o[d][4 * q], o[d][4 * q + 1]); w.y = cvtpk(o[d][4 * q + 2], o[d][4 * q + 3]); *(u32x2*)(Ow + (size_t)r32 * ldo + 32 * d + 8 * q + 4 * hi) = w; }
}
__device__ __forceinline__ void attn_phase(PPtr P, int li, LAS unsigned char* lds, int vcu, int wave, int lane) {
    bf16_t* proj = (bf16_t*)(P->ws + OFF_PROJ); bf16_t* mlaq = (bf16_t*)(P->ws + OFF_MLAQ); const bf16_t* mlakv = (const bf16_t*)(P->ws + OFF_MLAKV);
    const int r32 = lane & 31, hi = lane >> 5;
    {
        const int b = vcu >> 6, h = (vcu >> 4) & 3, qb = vcu & 15;
        const size_t seq0 = (size_t)b * SEQL, qrow = seq0 + qb * 256 + wave * 32;
        const float slope = __builtin_amdgcn_exp2f(-2.f * (float)(h + 1));
        f32x16 o1[4], o2[4];
        attn_pass<64, 128, true>(lds, proj + qrow * LDP + C_AQ + h * 128, LDP, nullptr, 0, proj + seq0 * LDP + C_AK + h * 128, LDP, nullptr, 0, proj + seq0 * LDP + C_AV + h * 128, LDP, qb * 256 + wave * 32, 0.125f * LOG2E, slope * LOG2E, nullptr, o1);
        LAS unsigned* o1s = (LAS unsigned*)(lds + 81920 + wave * 8192) + lane;
#pragma unroll
        for (int d = 0; d < 4; ++d)
#pragma unroll
            for (int r = 0; r < 8; ++r) o1s[(d * 8 + r) * 64] = cvtpk(o1[d][2 * r], o1[d][2 * r + 1]);
        attn_pass<64, 128, true>(lds, proj + qrow * LDP + C_AQ + h * 128 + 64, LDP, nullptr, 0, proj + seq0 * LDP + C_AK + h * 128 + 64, LDP, nullptr, 0, proj + seq0 * LDP + C_AV + h * 128, LDP, qb * 256 + wave * 32, 0.125f * LOG2E, slope * LOG2E, nullptr, o2);
        const float s1 = wave_sum(P->in[7][li * 64 + lane] * P->in[8][li * 64 + lane]), s2 = wave_sum(P->in[9][li * 64 + lane] * P->in[10][li * 64 + lane]);
        const float lam_init = 0.8f - 0.6f * expf(-0.3f * (float)li); const float lam = expf(s1) - expf(s2) + lam_init;
        float ss = 0.f;
#pragma unroll
        for (int d = 0; d < 4; ++d)
#pragma unroll
            for (int r = 0; r < 8; ++r) { const unsigned w = o1s[(d * 8 + r) * 64]; const float v0 = bflo(w) - lam * o2[d][2 * r], v1 = bfhi(w) - lam * o2[d][2 * r + 1]; o1[d][2 * r] = v0; o1[d][2 * r + 1] = v1; ss += v0 * v0 + v1 * v1; }
        ss += __shfl_xor(ss, 32);
        const float rs = __builtin_amdgcn_rsqf(ss * (1.f / 128) + EPSN) * (1.f - lam_init);
        const float* sub = P->in[11] + li * 128;
#pragma unroll
        for (int d = 0; d < 4; ++d)
#pragma unroll
            for (int q = 0; q < 4; ++q) { const f32x4 gg = *(const f32x4*)(sub + 32 * d + 8 * q + 4 * hi);
                o1[d][4 * q] *= rs * gg[0]; o1[d][4 * q + 1] *= rs * gg[1]; o1[d][4 * q + 2] *= rs * gg[2]; o1[d][4 * q + 3] *= rs * gg[3]; }
        attn_store<4>(o1, proj + qrow * LDP + C_AQ + h * 128, LDP, r32, hi);
    }
#pragma unroll 1
    for (int k = 0; k < 2; ++k) {
        const int idx = vcu + 256 * k; const int b = idx >> 7, qh = (idx >> 4) & 7, qb = idx & 15, kvh = qh >> 2;
        const size_t seq0 = (size_t)b * SEQL, qrow = seq0 + qb * 256 + wave * 32;
        f32x16 o[2];
        attn_pass<64, 64, false>(lds, proj + qrow * LDP + C_BQ + qh * 64, LDP, nullptr, 0, proj + seq0 * LDP + C_BK + kvh * 64, LDP, nullptr, 0, proj + seq0 * LDP + C_BV + kvh * 64, LDP, 0, 0.125f * LOG2E, 0.f, nullptr, o);
        attn_store<2>(o, proj + qrow * LDP + C_BQ + qh * 64, LDP, r32, hi);
    }
#pragma unroll 1
    for (int k = 0; k < 2; ++k) {
        const int idx = vcu + 256 * k; const int b = idx >> 7, h = (idx >> 4) & 7, qb = idx & 15;
        const size_t seq0 = (size_t)b * SEQL, qrow = seq0 + qb * 256 + wave * 32;
        f32x16 o[2];
        attn_pass<96, 64, false>(lds, mlaq + qrow * 768 + h * 64, 768, mlaq + qrow * 768 + 512 + h * 32, 768, mlakv + seq0 * 1024 + h * 128, 1024, proj + seq0 * LDP + C_CKR, LDP,
                                 mlakv + seq0 * 1024 + h * 128 + 64, 1024, qb * 256 + wave * 32, 0.10206207261596575f * LOG2E, 0.f, (const float*)(P->ws + OFF_ROPE), o);
        attn_store<2>(o, mlaq + qrow * 768 + h * 64, 768, r32, hi);
    }
}

#define XB_TMO      128
#define XB_XCNT(j)  (256  + 64 * (j))
#define XB_XSUB(j)  (1280 + 64 * (j))
#define XB_XGEN(j)  (2304 + 64 * (j))
#define XB_TOP      3328
#define XB_TOPGEN   3392
#define XCD_BAR_WORDS 3456
#define XB_SPIN_CAP (1u << 18)

__device__ __forceinline__ unsigned xb_ld(unsigned* p)              { return __hip_atomic_load(p, __ATOMIC_RELAXED, __HIP_MEMORY_SCOPE_AGENT); }
__device__ __forceinline__ unsigned xb_add(unsigned* p, unsigned v) { return __hip_atomic_fetch_add(p, v, __ATOMIC_RELAXED, __HIP_MEMORY_SCOPE_AGENT); }
__device__ __forceinline__ unsigned xb_xcc_id() { return (unsigned)__builtin_amdgcn_s_getreg((3 << 11) | 20) & 0xFu; }
#define XB_SPIN(cond, bar) do { unsigned _sp = 0; while (cond) { __builtin_amdgcn_s_sleep(1); \
    if ((++_sp & 255u) == 0u) { if (xb_ld(&(bar)[XB_TMO])) break; if (_sp > XB_SPIN_CAP) { atomicAdd(&(bar)[XB_TMO], 1u); break; } } } } while (0)

struct XcdBarrier {
    unsigned* bar; unsigned x;
    volatile LAS unsigned* st;
};

__device__ __forceinline__ XcdBarrier xcd_barrier_post(unsigned* bar, volatile LAS unsigned* st) {
    XcdBarrier b; b.bar = bar; b.x = xb_xcc_id(); b.st = st;
    if (threadIdx.x == 0) (void)xb_add(&bar[XB_XCNT(b.x)], 1u);
    return b;
}
__device__ __forceinline__ void xcd_barrier_complete(unsigned* bar, unsigned x, unsigned& nloc, unsigned& nx) {
    const unsigned G = gridDim.x * gridDim.y * gridDim.z;
    unsigned sum, cnt, mine, sp = 0u;
    for (;;) {
        sum = 0u; cnt = 0u; mine = 0u;
#pragma unroll
        for (unsigned j = 0; j < 16; ++j) { const unsigned c = xb_ld(&bar[XB_XCNT(j)]); sum += c; cnt += (c > 0u) ? 1u : 0u; mine = (j == x) ? c : mine; }
        if (sum == G) break;
        __builtin_amdgcn_s_sleep(1);
        if ((++sp & 255u) == 0u) { if (xb_ld(&bar[XB_TMO])) break; if (sp > XB_SPIN_CAP) { atomicAdd(&bar[XB_TMO], 1u); break; } }
    }
    nloc = mine > 0u ? mine : 1u; nx = cnt > 0u ? cnt : 1u;
}

__device__ __forceinline__ void xcd_barrier(const XcdBarrier& b) {
    asm volatile("s_waitcnt vmcnt(0)" ::: "memory");
    __syncthreads();
    if (threadIdx.x == 0) {
        unsigned* bar = b.bar;
        __builtin_amdgcn_s_waitcnt(0);
        unsigned nloc = b.st[0], nx = b.st[1];
        if (nloc == 0u) { xcd_barrier_complete(bar, b.x, nloc, nx); b.st[0] = nloc; b.st[1] = nx; }
        const unsigned old = xb_add(&bar[XB_XSUB(b.x)], 1u);
        const unsigned gen = old / nloc;
        if (old + 1u == (gen + 1u) * nloc) {
            __builtin_amdgcn_fence(__ATOMIC_RELEASE, "agent");
            asm volatile("s_waitcnt vmcnt(0)" ::: "memory");
            const unsigned og = xb_add(&bar[XB_TOP], 1u);
            const unsigned tg = og / nx;
            if (og + 1u == (tg + 1u) * nx) xb_add(&bar[XB_TOPGEN], 1u);
            else XB_SPIN(xb_ld(&bar[XB_TOPGEN]) == tg, bar);
            __builtin_amdgcn_fence(__ATOMIC_ACQUIRE, "agent");
            xb_add(&bar[XB_XGEN(b.x)], 1u);
            asm volatile("s_waitcnt vmcnt(0)" ::: "memory");
        } else {
            XB_SPIN(xb_ld(&bar[XB_XGEN(b.x)]) == gen, bar);
            __builtin_amdgcn_fence(__ATOMIC_ACQUIRE, "agent");
            asm volatile("s_waitcnt vmcnt(0)" ::: "memory");
        }
    }
    __syncthreads();
}

template <int ph> __device__ __forceinline__ void phase_body(LAS unsigned char* lds, int vcu, int NGW) {
        PPtr P = (PPtr)__builtin_amdgcn_kernarg_segment_ptr(); asm volatile("" : "+s"(P));
        bf16_t* proj = (bf16_t*)(P->ws + OFF_PROJ); bf16_t* mlaq = (bf16_t*)(P->ws + OFF_MLAQ); bf16_t* mlakv = (bf16_t*)(P->ws + OFF_MLAKV); bf16_t* xn = (bf16_t*)(P->ws + OFF_XN); bf16_t* yd = (bf16_t*)(P->ws + OFF_YD);
        const bf16_t* Wb = (const bf16_t*)(P->ws + OFF_W); float* rope = (float*)(P->ws + OFF_ROPE);
        bf16_t* hid = proj; bf16_t* mixed = mlakv; bf16_t* tmp1 = proj; bf16_t* tmp2 = xn; bf16_t* gatebuf = proj + C_AK;
        int tid_ = threadIdx.x; asm volatile("" : "+v"(tid_));
        const int lane = tid_ & 63, wave = __builtin_amdgcn_readfirstlane(tid_ >> 6), gw = vcu * 8 + wave;
        if constexpr (ph == 0) { if (PHON(0)) {
            const float invf[16] = {1.0f, 0.5623413324356079f, 0.3162277638912201f, 0.17782793939113617f, 0.10000000149011612f, 0.05623413249850273f, 0.03162277489900589f, 0.017782794311642647f,
                                    0.009999999776482582f, 0.005623413249850273f, 0.003162277629598975f, 0.0017782794311642647f, 0.0010000000474974513f, 0.000562341301701963f, 0.0003162277571391314f, 0.00017782794020604342f};
            for (int i = gw * 64 + lane; i < SEQL * 16; i += NGW * 64) {
                const int j = i & 15; float fv = invf[0];
#pragma unroll
                for (int q = 1; q < 16; ++q) fv = (j == q) ? invf[q] : fv;
                const float ang = (float)(i >> 4) * fv; float s, c; sincos_d((double)ang, s, c); rope[2 * i] = c; rope[2 * i + 1] = s;
            }
            convert_weights(P, 0, lds, gw, NGW, wave, lane);
            prenorm_rows(P->in[0], P->in[1], xn, gw, NGW, lane); }
        } else {
            constexpr int li = (ph - 1) / 10, k = (ph - 1) % 10 + 1;
            if constexpr (k == 1) { if (PHON(1)) {
                EpiB<0> E{proj, LDP, LDP, nullptr, 0, nullptr};
                run_gemm<0>(lds, xn, 1024, Wb + W_IN, 1024, NTOK, NPAD_IN, 1024, E);
            } } else if constexpr (k == 2) { if (PHON(2)) {
                prep_rows(proj, P->in[12] + li * 64, P->in[13] + li * 64, P->in[14] + li * 256, P->in[15] + li * 128, rope, gw, NGW, lane);
                s5n_pass1(P, li, lds, gw, NGW, wave, lane);
            } } else if constexpr (k == 3) { if (PHON(3)) {
#ifndef NO_G3
                { EpiB<0> E{mlaq, 768, 768, nullptr, 0, nullptr}; run_gemm<0>(lds, proj + C_CQ, LDP, Wb + W_UQ, 256, NTOK, 768, 256, E); }
                { EpiB<0> E{mlakv, 1024, 1024, nullptr, 0, nullptr}; run_gemm<0>(lds, proj + C_CKV, LDP, Wb + W_UKV, 128, NTOK, 1024, 128, E); }
#endif
#ifndef NO_S5P2
                s5h_pass2(P, li, lds, gw, NGW, wave, lane);
#endif
            } } else if constexpr (k == 4) { if (PHON(4)) {
#ifndef NO_ATTN
                attn_phase(P, li, lds, vcu, wave, lane);
#endif
                __syncthreads();
#ifndef NO_GLU
                { EpiB<3> E{yd, 512, 512, nullptr, 0, nullptr}; run_gemm<3>(lds, proj + C_DU, LDP, Wb + W_GLU, 512, NTOK, 1024, 512, E); }
#endif
            } } else if constexpr (k == 5) { if (PHON(5)) {
#pragma unroll 1
                for (int b = 0; b < 4; ++b) {
                    { EpiB<1> E{gatebuf, LDP, 1024, nullptr, 0, nullptr}; run_gemm<1>(lds, xn, 1024, Wb + W_GATE + (size_t)b * 1024 * 1024, 1024, NTOK, 1024, 1024, E); }
                    const bf16_t* ya = b == 0 ? proj + C_AQ : b == 1 ? proj + C_BQ : b == 2 ? mlaq : yd; const int lda = b < 2 ? LDP : b == 2 ? 768 : 512;
                    if (b == 0) { EpiB<4> E{mixed, 1024, 1024, gatebuf, LDP, nullptr}; run_gemm<4>(lds, ya, lda, Wb + W_BR + (size_t)b * 524288, 512, NTOK, 1024, 512, E); }
                    else { EpiB<5> E{mixed, 1024, 1024, gatebuf, LDP, nullptr}; run_gemm<5>(lds, ya, lda, Wb + W_BR + (size_t)b * 524288, 512, NTOK, 1024, 512, E); }
                }
            } } else if constexpr (k == 6) { if (PHON(6)) {
                EpiB<0> E{tmp1, 1024, 1024, nullptr, 0, nullptr}; run_gemm<0>(lds, mixed, 1024, Wb + W_OUT, 1024, NTOK, 1024, 1024, E);
            } } else if constexpr (k == 7) { if (PHON(7)) {
                resnorm_rows(li == 0 ? P->in[0] : P->out, tmp1, P->in[2] + li * 1024, P->out, P->in[3] + li * 1024, xn, gw, NGW, lane);
            } } else if constexpr (k == 8) { if (PHON(8)) {
                EpiB<2> E{hid, 4096, 4096, nullptr, 0, nullptr}; run_gemm<2>(lds, xn, 1024, Wb + W_F1, 1024, NTOK, 4096, 1024, E);
            } } else if constexpr (k == 9) { if (PHON(9)) {
                EpiB<0> E{tmp2, 1024, 1024, nullptr, 0, nullptr}; run_gemm<0>(lds, hid, 4096, Wb + W_F2, 4096, NTOK, 1024, 4096, E);
            } } else { if (PHON(10)) {
                const bool last = (li == DEPTH_ - 1);
                resnorm_rows(P->out, tmp2, P->in[4] + li * 1024, P->out, last ? nullptr : P->in[1] + (li + 1) * 1024, xn, gw, NGW, lane);
                if (!last) convert_weights(P, li + 1, lds, gw, NGW, wave, lane);
            } }
        }
}
__global__ void __launch_bounds__(512, 2) fwd_mega(Params Pv) {
    extern __shared__ __attribute__((aligned(16))) unsigned char lds_raw[];
    LAS unsigned char* lds = (LAS unsigned char*)lds_raw;
    const int G = gridDim.x, bx = blockIdx.x; const int vcu = (G % 8 == 0) ? (bx % 8) * (G / 8) + bx / 8 : bx; const int NGW = G * 8;
    const int ph_lo = Pv.ph_lo, ph_hi = Pv.ph_hi;
    volatile LAS unsigned* bst = (volatile LAS unsigned*)(lds + 147456);
    if (threadIdx.x < 2) bst[threadIdx.x] = 0u;
    __syncthreads();
    XcdBarrier xbar = xcd_barrier_post((unsigned*)(Pv.ws + OFF_CTL), bst);
#define PHASE(n) if (ph_lo <= (n) && (n) < ph_hi) { phase_body<n>(lds, vcu, NGW); if ((n) + 1 < ph_hi) { if (ph_hi > NPHASE) { __syncthreads(); cg::this_grid().sync(); } else xcd_barrier(xbar); } }
    PHASE(0) PHASE(1) PHASE(2) PHASE(3) PHASE(4) PHASE(5) PHASE(6) PHASE(7) PHASE(8) PHASE(9) PHASE(10)
    PHASE(11) PHASE(12) PHASE(13) PHASE(14) PHASE(15) PHASE(16) PHASE(17) PHASE(18) PHASE(19) PHASE(20)
#undef PHASE
}

extern "C" void kernel_launch(void* const* d_in, const int* in_sizes, int n_in, void* d_out, int out_size, void* d_ws, size_t ws_size, hipStream_t stream) {
    static int ready = 0;
    if (!ready) {
        if (n_in != 34 || out_size != NTOK * DMODEL || ws_size < WS_NEED) { fprintf(stderr, "kernel_launch: unexpected shapes (n_in %d out %d ws %zu)\n", n_in, out_size, ws_size); ready = -1; return; }
        if (hipFuncSetAttribute((const void*)fwd_mega, hipFuncAttributeMaxDynamicSharedMemorySize, LDS_BYTES) != hipSuccess) { fprintf(stderr, "kernel_launch: hipFuncSetAttribute failed\n"); ready = -1; return; }
        int per_cu = 0; (void)hipOccupancyMaxActiveBlocksPerMultiprocessor(&per_cu, (const void*)fwd_mega, 512, LDS_BYTES); (void)hipGetLastError();
        if (per_cu < 1) fprintf(stderr, "kernel_launch: occupancy query says %d blocks per CU\n", per_cu);
        ready = 1;
    }
    if (ready < 0) return;
    Params p{};
    for (int i = 0; i < 34; ++i) p.in[i] = (const float*)d_in[i];
    p.out = (float*)d_out; p.ws = (unsigned char*)d_ws;
#if MK_ONE_LAUNCH
    p.ph_lo = 0; p.ph_hi = NPHASE;
    if (hipMemsetAsync((char*)d_ws + OFF_CTL, 0, CTL_BYTES, stream) != hipSuccess) { fprintf(stderr, "kernel_launch: hipMemsetAsync failed\n"); return; }
    void* args[] = {&p};
    hipError_t e = hipLaunchCooperativeKernel((const void*)fwd_mega, dim3(256), dim3(512), args, LDS_BYTES, stream);
    if (e != hipSuccess) fprintf(stderr, "cooperative launch failed: %s\n", hipGetErrorString(e));
#else
    for (int ph = 0; ph < NPHASE; ++ph) { p.ph_lo = ph; p.ph_hi = ph + 1; hipLaunchKernelGGL(fwd_mega, dim3(256), dim3(512), LDS_BYTES, stream, p); }
#endif
}
```

```cpp
#include <hip/hip_runtime.h>
#include <hip/hip_cooperative_groups.h>
#include <cstdio>
#include <cstdint>
namespace cg = cooperative_groups;
#ifndef PHMASK
#define PHMASK 0x7ff
#endif
#define PHON(k) ((PHMASK >> (k)) & 1)
#ifndef MK_ONE_LAUNCH
#define MK_ONE_LAUNCH 1
#endif
namespace pg8 {
#define PG8_LAS __attribute__((address_space(3)))
typedef unsigned short bf16_t;
typedef short bf16x8 __attribute__((ext_vector_type(8)));
typedef float f32x4 __attribute__((ext_vector_type(4)));
typedef unsigned u32x4 __attribute__((ext_vector_type(4)));
constexpr int BM = 256, BK = 64, HALF = 128, HTB = HALF * BK * 2  , STAGE_BYTES = 8 * HTB, NXCD = 8, WGM = 8;

__host__ __device__ __forceinline__ int lds_byte(int r, int c) { const int st = (r >> 4) * 2 + (c >> 5), rr = r & 15, cc = c & 31, ob = rr * 64 + cc * 2; return st * 1024 + (ob ^ (((ob >> 9) & 1) << 5)); }
__host__ __device__ __forceinline__ void stage_rc(int b, int& R, int& C) { const int st = b / 1024, sb = b % 1024, swz = sb ^ (((sb >> 9) & 1) << 5); R = (st >> 1) * 16 + swz / 64; C = (st & 1) * 32 + (swz % 64) / 2; }
__host__ __device__ __forceinline__ int perm32(int rho) { const int n = rho >> 4, i = rho & 15; return 8 * (i >> 2) + 4 * n + (i & 3); }

struct Unit { int pm, pn; };
struct Gemm { const bf16_t* A; const bf16_t* Bt; int M, N, K, lda, ldb; };

struct StaticOrder {
    int nM, nN, nwg, G, c;
    __host__ __device__ void init(int M, int N, int G_, int c_) { nM = M / BM; nN = N / BM; nwg = nM * nN; G = G_; c = c_; }
    __host__ __device__ bool next(int i, Unit& u) const {
        const long L = (long)i * G + c; if (L >= nwg) return false;
        int wgid = (int)L; { const int q = nwg / NXCD, r = nwg % NXCD, xcd = wgid % NXCD, off = wgid / NXCD; wgid = (xcd < r ? xcd * (q + 1) : r * (q + 1) + (xcd - r) * q) + off; }
        const int nig = WGM * nN, gid = wgid / nig, fm = gid * WGM, gsz = (nM - fm) < WGM ? (nM - fm) : WGM;
        u.pm = fm + ((wgid % nig) % gsz); u.pn = (wgid % nig) / gsz; return true;
    }
    __device__ __forceinline__ void a_ready(const Unit&) const {}
    __device__ __forceinline__ void done(const Unit&) const {}
};

__device__ __forceinline__ unsigned cvt_pk_bf16(float lo, float hi) { unsigned r; asm volatile("v_cvt_pk_bf16_f32 %0, %1, %2" : "=v"(r) : "v"(lo), "v"(hi)); return r; }
template <class Epi, class Sched, bool ALIGN_EPI = false, bool SP2 = false>
__device__ __forceinline__ void gemm_phase(PG8_LAS unsigned char* lds, const Gemm g, const Sched& S, const Epi& E) {
    int tid_ = threadIdx.x; asm volatile("" : "+v"(tid_));
    const int tid = tid_, wid = __builtin_amdgcn_readfirstlane(tid >> 6), lane = tid & 63, wr = wid >> 2, wc = wid & 3, fr = lane & 15, fq = lane >> 4;
    const int K = g.K, nt = K / BK;
    unsigned voffA[2], voffB[2];
#pragma unroll
    for (int i = 0; i < 2; ++i) { int R, C; stage_rc(tid * 16 + i * 8192, R, C); const int Rb = Epi::PERM ? ((R & ~31) + perm32(R & 31)) : R;
        voffA[i] = (unsigned)(R * g.lda + C) * 2u; voffB[i] = (unsigned)(Rb * g.ldb + C) * 2u; }
    const size_t kstep = (size_t)(BK * 2);
    const size_t hstepA = (size_t)HALF * g.lda * 2, hstepB = (size_t)HALF * g.ldb * 2;
    const size_t tstepA = 2 * hstepA, tstepB = 2 * hstepB;
    const unsigned ldsw = (unsigned)wid * 1024u;
    const int aoff = lds_byte(wr * 64 + fr, fq * 8), boff = lds_byte(wc * 32 + fr, fq * 8);
#define PG8_SA(b, h) (((b) * 2 + (h)) * HTB)
#define PG8_SB(b, h) ((4 + (b) * 2 + (h)) * HTB)
#define PG8_STAGE(bufoff, gbase, voff) do { _Pragma("unroll") for (int _i = 0; _i < 2; ++_i) \
        __builtin_amdgcn_global_load_lds((const unsigned*)((const char*)(gbase) + (voff)[_i]), (PG8_LAS unsigned*)(lds + (bufoff) + ldsw + _i * 8192), 16, 0, 0); } while (0)
#define PG8_LDA(dst, b, h) do { _Pragma("unroll") for (int m = 0; m < 4; ++m) _Pragma("unroll") for (int k = 0; k < 2; ++k) dst[m][k] = *(const PG8_LAS bf16x8*)(lds + PG8_SA(b, h) + aoff + m * 2048 + k * 1024); } while (0)
#define PG8_LDB(dst, b, h) do { _Pragma("unroll") for (int n = 0; n < 2; ++n) _Pragma("unroll") for (int k = 0; k < 2; ++k) dst[n][k] = *(const PG8_LAS bf16x8*)(lds + PG8_SB(b, h) + boff + n * 2048 + k * 1024); } while (0)
#define PG8_MMA(ai, bj, At, Bt) do { __builtin_amdgcn_s_setprio(1); _Pragma("unroll") for (int m = 0; m < 4; ++m) _Pragma("unroll") for (int n = 0; n < 2; ++n) _Pragma("unroll") for (int k = 0; k < 2; ++k) \
        acc[ai][bj][m][n] = __builtin_amdgcn_mfma_f32_16x16x32_bf16(Bt[n][k], At[m][k], acc[ai][bj][m][n], 0, 0, 0); __builtin_amdgcn_s_setprio(0); } while (0)
#define PG8_WAIT_V(n) asm volatile("s_waitcnt vmcnt(" #n ")" ::: "memory")
#define PG8_WAIT_L(n) asm volatile("s_waitcnt lgkmcnt(" #n ")" ::: "memory")
#define PG8_BAR __builtin_amdgcn_s_barrier()
#define PG8_SCHED __builtin_amdgcn_sched_barrier(0)
    Unit cur, nxt; int ui = 0;
    if (!S.next(0, cur)) return;
    f32x4 acc[2][2][4][2];
#pragma unroll
    for (int a = 0; a < 2; ++a)
#pragma unroll
        for (int b = 0; b < 2; ++b)
#pragma unroll
            for (int m = 0; m < 4; ++m)
#pragma unroll
                for (int n = 0; n < 2; ++n) acc[a][b][m][n] = (f32x4){0.f, 0.f, 0.f, 0.f};
    bf16x8 At[4][2], B0[2][2], B1[2][2];
    const char* cA = (const char*)g.A + (size_t)cur.pm * tstepA; const char* cB = (const char*)g.Bt + (size_t)cur.pn * tstepB;
    S.a_ready(cur);
    if constexpr (SP2) {
        PG8_STAGE(PG8_SB(0, 0), cB, voffB); PG8_STAGE(PG8_SB(0, 1), cB + hstepB, voffB); PG8_STAGE(PG8_SA(0, 0), cA, voffA); PG8_STAGE(PG8_SA(0, 1), cA + hstepA, voffA);
        if (wr == 1) PG8_BAR;
        PG8_WAIT_V(2); PG8_BAR;
        PG8_STAGE(PG8_SB(1, 0), cB + kstep, voffB); PG8_STAGE(PG8_SA(1, 0), cA + kstep, voffA); PG8_STAGE(PG8_SB(1, 1), cB + hstepB + kstep, voffB);
        PG8_WAIT_V(6); PG8_BAR;
    } else {
        PG8_STAGE(PG8_SB(0, 0), cB, voffB); PG8_STAGE(PG8_SA(0, 0), cA, voffA); PG8_STAGE(PG8_SB(0, 1), cB + hstepB, voffB); PG8_STAGE(PG8_SA(0, 1), cA + hstepA, voffA);
        if (wr == 1) PG8_BAR;
        PG8_WAIT_V(4); PG8_BAR;
        PG8_STAGE(PG8_SB(1, 0), cB + kstep, voffB); PG8_STAGE(PG8_SA(1, 0), cA + kstep, voffA); PG8_STAGE(PG8_SB(1, 1), cB + hstepB + kstep, voffB);
        PG8_WAIT_V(6); PG8_BAR;
    }
    for (;;) {
        const bool has_next = S.next(ui + 1, nxt);
        const char* nA = has_next ? (const char*)g.A + (size_t)nxt.pm * tstepA : cA; const char* nB = has_next ? (const char*)g.Bt + (size_t)nxt.pn * tstepB : cB;
        for (int t = 0; t < nt; t += 2) {
            const bool last = (t == nt - 2);
            const char* a1 = cA + (size_t)(t + 1) * kstep;
            const char* a2 = last ? nA : cA + (size_t)(t + 2) * kstep; const char* b2 = last ? nB : cB + (size_t)(t + 2) * kstep;
            const char* a3 = a2 + kstep; const char* b3 = b2 + kstep;
            if (last && has_next) S.a_ready(nxt);
            if constexpr (SP2) {
            PG8_LDB(B0, 0, 0); PG8_LDB(B1, 0, 1); PG8_SCHED; PG8_LDA(At, 0, 0); PG8_STAGE(PG8_SA(1, 1), a1 + hstepA, voffA);
            PG8_WAIT_V(8); PG8_WAIT_L(0); PG8_BAR; PG8_MMA(0, 0, At, B0); PG8_MMA(0, 1, At, B1); PG8_BAR; PG8_SCHED;
            PG8_LDA(At, 0, 1); PG8_STAGE(PG8_SB(0, 0), b2, voffB); PG8_STAGE(PG8_SB(0, 1), b2 + hstepB, voffB); PG8_STAGE(PG8_SA(0, 0), a2, voffA);
            PG8_WAIT_V(8); PG8_WAIT_L(0); PG8_BAR; PG8_MMA(1, 0, At, B0); PG8_MMA(1, 1, At, B1); PG8_BAR; PG8_SCHED;
            PG8_LDB(B0, 1, 0); PG8_LDB(B1, 1, 1); PG8_SCHED; PG8_LDA(At, 1, 0); PG8_STAGE(PG8_SA(0, 1), a2 + hstepA, voffA);
            PG8_WAIT_V(8); PG8_WAIT_L(0); PG8_BAR; PG8_MMA(0, 0, At, B0); PG8_MMA(0, 1, At, B1); PG8_BAR; PG8_SCHED;
            PG8_LDA(At, 1, 1); PG8_STAGE(PG8_SB(1, 0), b3, voffB); PG8_STAGE(PG8_SB(1, 1), b3 + hstepB, voffB); PG8_STAGE(PG8_SA(1, 0), a3, voffA);
            PG8_WAIT_V(8); PG8_WAIT_L(0); PG8_BAR; PG8_MMA(1, 0, At, B0); PG8_MMA(1, 1, At, B1); PG8_BAR; PG8_SCHED;
            } else {
            PG8_LDB(B0, 0, 0); PG8_SCHED; PG8_LDA(At, 0, 0); PG8_STAGE(PG8_SA(1, 1), a1 + hstepA, voffA);
            PG8_WAIT_L(8); PG8_BAR; PG8_WAIT_L(0); PG8_MMA(0, 0, At, B0); PG8_BAR; PG8_SCHED;
            PG8_LDB(B1, 0, 1); PG8_STAGE(PG8_SB(0, 0), b2, voffB);
            PG8_BAR; PG8_WAIT_L(0); PG8_MMA(0, 1, At, B1); PG8_BAR;
            PG8_LDA(At, 0, 1); PG8_STAGE(PG8_SA(0, 0), a2, voffA);
            PG8_BAR; PG8_WAIT_L(0); PG8_MMA(1, 0, At, B0); PG8_BAR; PG8_SCHED;
            PG8_STAGE(PG8_SB(0, 1), b2 + hstepB, voffB);
            PG8_WAIT_V(6); PG8_BAR; PG8_MMA(1, 1, At, B1); PG8_BAR;
            PG8_LDB(B0, 1, 0); PG8_SCHED; PG8_LDA(At, 1, 0); PG8_STAGE(PG8_SA(0, 1), a2 + hstepA, voffA);
            PG8_WAIT_L(8); PG8_BAR; PG8_WAIT_L(0); PG8_MMA(0, 0, At, B0); PG8_BAR; PG8_SCHED;
            PG8_LDB(B1, 1, 1); PG8_STAGE(PG8_SB(1, 0), b3, voffB);
            PG8_BAR; PG8_WAIT_L(0); PG8_MMA(0, 1, At, B1); PG8_BAR;
            PG8_LDA(At, 1, 1); PG8_STAGE(PG8_SA(1, 0), a3, voffA);
            PG8_BAR; PG8_WAIT_L(0); PG8_MMA(1, 0, At, B0); PG8_BAR; PG8_SCHED;
            PG8_STAGE(PG8_SB(1, 1), b3 + hstepB, voffB);
            PG8_WAIT_V(6); PG8_BAR; PG8_MMA(1, 1, At, B1); PG8_BAR;
            }
        }
        if constexpr (ALIGN_EPI) { if (wr == 0) PG8_BAR; }
        if constexpr (!Epi::AFTER_DRAIN) { E(acc, cur, wr, wc, fr, fq); S.done(cur); }
        if (!has_next) break;
#pragma unroll
        for (int a = 0; a < 2; ++a)
#pragma unroll
            for (int b = 0; b < 2; ++b)
#pragma unroll
                for (int m = 0; m < 4; ++m)
#pragma unroll
                    for (int n = 0; n < 2; ++n) acc[a][b][m][n] = (f32x4){0.f, 0.f, 0.f, 0.f};
        cur = nxt; cA = nA; cB = nB; ++ui;
        if constexpr (ALIGN_EPI) { if (wr == 1) PG8_BAR; }
    }
    PG8_WAIT_V(0);
    if constexpr (!ALIGN_EPI) { if (wr == 0) PG8_BAR; }
    PG8_BAR;
    if constexpr (Epi::AFTER_DRAIN) { E.fused(acc, cur, wr, wc, fr, fq, lds, wid, lane); S.done(cur); }
#undef PG8_SA
#undef PG8_SB
#undef PG8_STAGE
#undef PG8_LDA
#undef PG8_LDB
#undef PG8_MMA
#undef PG8_WAIT_V
#undef PG8_WAIT_L
#undef PG8_BAR
#undef PG8_SCHED
}
}

#define LAS __attribute__((address_space(3)))
typedef unsigned short bf16_t;
typedef short bf16x8 __attribute__((ext_vector_type(8)));
typedef float f32x4 __attribute__((ext_vector_type(4)));
typedef float f32x16 __attribute__((ext_vector_type(16)));
typedef unsigned u32x4 __attribute__((ext_vector_type(4)));
typedef unsigned u32x2 __attribute__((ext_vector_type(2)));
typedef float f32x2 __attribute__((ext_vector_type(2)));

constexpr int NTOK = 16384, DMODEL = 1024, SEQL = 4096, NBATCH = 4, DEPTH_ = 2, FFH = 4096;
constexpr int LDP = 3232;
constexpr int C_AQ = 0, C_AK = 512, C_AV = 1024, C_BQ = 1536, C_BK = 2048, C_BV = 2176, C_CQ = 2304, C_CKV = 2560, C_CKR = 2688, C_DU = 2720;
constexpr int NPAD_IN = 3328;
constexpr float EPSN = 1e-6f;
constexpr float LOG2E = 1.4426950408889634f;
constexpr size_t MiB = 1u << 20;
constexpr size_t OFF_PROJ = 0, OFF_MLAQ = 101 * MiB, OFF_MLAKV = 125 * MiB, OFF_XN = 157 * MiB, OFF_YD = 189 * MiB, OFF_W = 205 * MiB, OFF_CARRY = 244 * MiB, OFF_ROPE = 248 * MiB, WS_NEED = 252 * MiB;
constexpr size_t W_IN = 0, W_GATE = 3407872, W_UQ = 7602176, W_UKV = 7798784, W_GLU = 7929856, W_BR = 8454144, W_OUT = 10551296, W_F1 = 11599872, W_F2 = 15794176;
constexpr int LDS_BYTES = 148480;
constexpr size_t OFF_CTL = 251 * MiB, CTL_BYTES = 16384;
constexpr int NPHASE = 1 + 10 * DEPTH_;
constexpr int S5_CH = 128, S5_NCH = SEQL / S5_CH;

struct Params { const float* in[34]; float* out; unsigned char* ws; int ph_lo, ph_hi; };
typedef const __attribute__((address_space(4))) Params* PPtr;

__device__ __forceinline__ float wave_sum(float v) {
#pragma unroll
    for (int o = 1; o < 64; o <<= 1) v += __shfl_xor(v, o);
    return v;
}
__device__ __forceinline__ unsigned cvtpk(float lo, float hi) { typedef __bf16 bf2 __attribute__((ext_vector_type(2))); f32x2 v = {lo, hi}; bf2 b = __builtin_convertvector(v, bf2); return __builtin_bit_cast(unsigned, b); }
__device__ __forceinline__ float bflo(unsigned w) { return __builtin_bit_cast(float, w << 16); }
__device__ __forceinline__ float bfhi(unsigned w) { return __builtin_bit_cast(float, w & 0xffff0000u); }
__device__ __forceinline__ float bf1(bf16_t h) { return __builtin_bit_cast(float, (unsigned)h << 16); }
__device__ __forceinline__ bf16_t tobf(float f) { return (bf16_t)(cvtpk(f, 0.f) & 0xffffu); }
__device__ __forceinline__ float fsigmoid(float x) { return __builtin_amdgcn_rcpf(1.f + __builtin_amdgcn_exp2f(-x * LOG2E)); }
__device__ __forceinline__ void sincos_d(double a, float& s, float& c) {
    const double k = __builtin_rint(a * 0.15915494309189535); const double r = a - k * 6.283185307179586476925;
    const double x = r * 0.25, x2 = x * x;
    const double sn = x * (1.0 + x2 * (-1.0 / 6 + x2 * (1.0 / 120 + x2 * (-1.0 / 5040 + x2 * (1.0 / 362880 + x2 * (-1.0 / 39916800 + x2 * (1.0 / 6227020800.0)))))));
    const double cs = 1.0 + x2 * (-0.5 + x2 * (1.0 / 24 + x2 * (-1.0 / 720 + x2 * (1.0 / 40320 + x2 * (-1.0 / 3628800 + x2 * (1.0 / 479001600.0 + x2 * (-1.0 / 87178291200.0)))))));
    const double s2 = 2 * sn * cs, c2 = 1 - 2 * sn * sn; s = (float)(2 * s2 * c2); c = (float)(1 - 2 * s2 * s2);
}

__device__ __forceinline__ void st16_wt(void* p, u32x4 v) { asm volatile("global_store_dwordx4 %0, %1, off sc1\n\ts_nop 4" :: "v"(p), "v"(v) : "memory"); }
template <int MODE> struct EpiB {
    static constexpr bool PERM = true, AFTER_DRAIN = false;
    bf16_t* O; int ldc; int ncols; const bf16_t* G; int ldg; const float* rope;
    __device__ __forceinline__ void operator()(const f32x4 (&acc)[2][2][4][2], const pg8::Unit& u, int wr, int wc, int fr, int fq) const {
        const int row0 = u.pm * 256 + wr * 64 + fr;
        if constexpr (MODE == 3) {
            const int col = u.pn * 128 + wc * 32 + 8 * fq;
#pragma unroll
            for (int ai = 0; ai < 2; ++ai)
#pragma unroll
                for (int m = 0; m < 4; ++m) {
                    const int row = row0 + ai * 128 + m * 16;
                    f32x4 v0 = acc[ai][0][m][0], v1 = acc[ai][0][m][1]; const f32x4 g0 = acc[ai][1][m][0], g1 = acc[ai][1][m][1];
#pragma unroll
                    for (int i = 0; i < 4; ++i) { v0[i] *= fsigmoid(g0[i]); v1[i] *= fsigmoid(g1[i]); }
                    u32x4 w; w.x = cvtpk(v0[0], v0[1]); w.y = cvtpk(v0[2], v0[3]); w.z = cvtpk(v1[0], v1[1]); w.w = cvtpk(v1[2], v1[3]);
                    st16_wt(O + (size_t)row * ldc + col, w);
                }
        } else {
#pragma unroll
            for (int ai = 0; ai < 2; ++ai)
#pragma unroll
                for (int m = 0; m < 4; ++m) {
                    const int row = row0 + ai * 128 + m * 16;
#pragma unroll
                    for (int bj = 0; bj < 2; ++bj) {
                        const int col = u.pn * 256 + bj * 128 + wc * 32 + 8 * fq;
                        if (col >= ncols) continue;
                        f32x4 v0 = acc[ai][bj][m][0], v1 = acc[ai][bj][m][1];
                        if constexpr (MODE == 1) {
#pragma unroll
                            for (int i = 0; i < 4; ++i) { v0[i] = fsigmoid(v0[i]); v1[i] = fsigmoid(v1[i]); }
                        }
                        if constexpr (MODE == 2) {
#pragma unroll
                            for (int i = 0; i < 4; ++i) { const float a = fmaxf(v0[i], 0.f), b = fmaxf(v1[i], 0.f); v0[i] = a * a; v1[i] = b * b; }
                        }
                        if constexpr (MODE == 4 || MODE == 5) {
                            const u32x4 gw = *(const u32x4*)(G + (size_t)row * ldg + col);
                            v0[0] *= bflo(gw.x); v0[1] *= bfhi(gw.x); v0[2] *= bflo(gw.y); v0[3] *= bfhi(gw.y);
                            v1[0] *= bflo(gw.z); v1[1] *= bfhi(gw.z); v1[2] *= bflo(gw.w); v1[3] *= bfhi(gw.w);
                            if constexpr (MODE == 5) {
                                const u32x4 ow = *(const u32x4*)(O + (size_t)row * ldc + col);
                                v0[0] += bflo(ow.x); v0[1] += bfhi(ow.x); v0[2] += bflo(ow.y); v0[3] += bfhi(ow.y);
                                v1[0] += bflo(ow.z); v1[1] += bfhi(ow.z); v1[2] += bflo(ow.w); v1[3] += bfhi(ow.w);
                            }
                        }
                        if constexpr (MODE == 6) {
                            if (col >= 512) {
                                const int pos = row & (SEQL - 1);
                                const f32x4 cs0 = *(const f32x4*)(rope + ((size_t)pos * 16 + 4 * fq) * 2), cs1 = *(const f32x4*)(rope + ((size_t)pos * 16 + 4 * fq + 2) * 2);
                                float a, b;
                                a = v0[0]; b = v0[1]; v0[0] = a * cs0[0] - b * cs0[1]; v0[1] = a * cs0[1] + b * cs0[0];
                                a = v0[2]; b = v0[3]; v0[2] = a * cs0[2] - b * cs0[3]; v0[3] = a * cs0[3] + b * cs0[2];
                                a = v1[0]; b = v1[1]; v1[0] = a * cs1[0] - b * cs1[1]; v1[1] = a * cs1[1] + b * cs1[0];
                                a = v1[2]; b = v1[3]; v1[2] = a * cs1[2] - b * cs1[3]; v1[3] = a * cs1[3] + b * cs1[2];
                            }
                        }
                        u32x4 w; w.x = cvtpk(v0[0], v0[1]); w.y = cvtpk(v0[2], v0[3]); w.z = cvtpk(v1[0], v1[1]); w.w = cvtpk(v1[2], v1[3]);
                        if constexpr (MODE == 0 || MODE == 2) st16_wt(O + (size_t)row * ldc + col, w); else *(u32x4*)(O + (size_t)row * ldc + col) = w;
                        if constexpr (MODE == 4 || MODE == 5) asm volatile("" ::: "memory");
                    }
                }
        }
    }
};

template <int MODE>
__device__ __forceinline__ void run_gemm(LAS unsigned char* lds, const bf16_t* A, int lda, const bf16_t* Bt, int ldb, int M, int N, int K, const EpiB<MODE>& E) {
    asm volatile("" : "+s"(K), "+s"(lda), "+s"(ldb), "+s"(N));
    pg8::Gemm g{A, Bt, M, N, K, lda, ldb}; pg8::StaticOrder S; S.init(M, N, (int)gridDim.x, (int)blockIdx.x);
    pg8::gemm_phase<EpiB<MODE>, pg8::StaticOrder, true, true>(lds, g, S, E);
}

__device__ __forceinline__ int wrow_map(int mode, int n) {
    if (mode == 1) { const int hd = n / 96, w = n % 96; return w < 64 ? hd * 64 + w : 512 + hd * 32 + 2 * ((w - 64) & 15) + ((w - 64) >> 4); }
    if (mode == 2) { const int c = n & 511, t = c >> 7; return 256 * t + (n >> 9) * 128 + (c & 127); }
    return n;
}
__device__ __forceinline__ void transpose_item(const float* W, int K, int N, bf16_t* WT, int mode, LAS float* scr, int item, int lane) {
    const int nblk = N / 32, kb = item / nblk, nb = item % nblk, k0 = 64 * kb, n0 = 32 * nb;
#pragma unroll
    for (int i = 0; i < 32; ++i) { const int kk = 2 * i + (lane >> 5); scr[kk * 33 + (lane & 31)] = W[(size_t)(k0 + kk) * N + n0 + (lane & 31)]; }
    asm volatile("s_waitcnt lgkmcnt(0)" ::: "memory");
    const int c = lane & 7;
#pragma unroll
    for (int j = 0; j < 4; ++j) { const int n = (lane >> 3) + 8 * j; const LAS float* s = scr + (8 * c) * 33 + n;
        u32x4 o; o.x = cvtpk(s[0 * 33], s[1 * 33]); o.y = cvtpk(s[2 * 33], s[3 * 33]); o.z = cvtpk(s[4 * 33], s[5 * 33]); o.w = cvtpk(s[6 * 33], s[7 * 33]);
        *(u32x4*)(WT + (size_t)wrow_map(mode, n0 + n) * K + k0 + 8 * c) = o; }
    asm volatile("s_waitcnt lgkmcnt(0)" ::: "memory");
}
__device__ __forceinline__ void convert_weights(PPtr P, int li, LAS unsigned char* lds, int gw, int NGW, int wave, int lane) {
    LAS float* scr = (LAS float*)(lds + wave * 16384);
    bf16_t* Wb = (bf16_t*)(P->ws + OFF_W);
    constexpr int I_IN = 16 * 101, I_GATE = 16 * 128, I_UQ = 4 * 24, I_UKV = 2 * 32, I_GLU = 8 * 32, I_BR = 8 * 32, I_OUT = 16 * 32, I_F1 = 16 * 128, I_F2 = 64 * 32;
    constexpr int NIT = I_IN + I_GATE + I_UQ + I_UKV + I_GLU + 4 * I_BR + I_OUT + I_F1 + I_F2;
    for (int it = gw; it < NIT; it += NGW) {
        int r = it;
        if (r < I_IN) { transpose_item(P->in[5] + (size_t)li * 1024 * 3232, 1024, 3232, Wb + W_IN, 0, scr, r, lane); continue; } r -= I_IN;
        if (r < I_GATE) { transpose_item(P->in[6] + (size_t)li * 1024 * 4096, 1024, 4096, Wb + W_GATE, 0, scr, r, lane); continue; } r -= I_GATE;
        if (r < I_UQ) { transpose_item(P->in[16] + (size_t)li * 256 * 768, 256, 768, Wb + W_UQ, 1, scr, r, lane); continue; } r -= I_UQ;
        if (r < I_UKV) { transpose_item(P->in[17] + (size_t)li * 128 * 1024, 128, 1024, Wb + W_UKV, 0, scr, r, lane); continue; } r -= I_UKV;
        if (r < I_GLU) { transpose_item(P->in[26] + (size_t)li * 512 * 1024, 512, 1024, Wb + W_GLU, 2, scr, r, lane); continue; } r -= I_GLU;
        if (r < 4 * I_BR) { const int b = r / I_BR; transpose_item(P->in[27 + b] + (size_t)li * 512 * 1024, 512, 1024, Wb + W_BR + (size_t)b * 524288, 0, scr, r % I_BR, lane); continue; } r -= 4 * I_BR;
        if (r < I_OUT) { transpose_item(P->in[31] + (size_t)li * 1024 * 1024, 1024, 1024, Wb + W_OUT, 0, scr, r, lane); continue; } r -= I_OUT;
        if (r < I_F1) { transpose_item(P->in[32] + (size_t)li * 1024 * 4096, 1024, 4096, Wb + W_F1, 0, scr, r, lane); continue; } r -= I_F1;
        transpose_item(P->in[33] + (size_t)li * 4096 * 1024, 4096, 1024, Wb + W_F2, 0, scr, r, lane);
    }
    for (int i = gw * 64 + lane; i < 12288; i += NGW * 64) *(u32x4*)(Wb + W_IN + (size_t)3232 * 1024 + (size_t)i * 8) = (u32x4){0u, 0u, 0u, 0u};
}

__device__ __forceinline__ void prenorm_rows(const float* x, const float* g, bf16_t* xn, int gw, int NGW, int lane) {
    for (int row = gw; row < NTOK; row += NGW) {
        const f32x4* xr = (const f32x4*)(x + (size_t)row * DMODEL) + lane; f32x4 v[4]; float ss = 0.f;
#pragma unroll
        for (int j = 0; j < 4; ++j) { v[j] = xr[64 * j]; ss += (v[j][0] * v[j][0] + v[j][1] * v[j][1]) + (v[j][2] * v[j][2] + v[j][3] * v[j][3]); }
        const float rs = __builtin_amdgcn_rsqf(wave_sum(ss) * (1.f / DMODEL) + EPSN);
        u32x2* o = (u32x2*)(xn + (size_t)row * DMODEL) + lane;
#pragma unroll
        for (int j = 0; j < 4; ++j) { const f32x4 gg = ((const f32x4*)g)[lane + 64 * j]; u32x2 w; w.x = cvtpk(v[j][0] * rs * gg[0], v[j][1] * rs * gg[1]); w.y = cvtpk(v[j][2] * rs * gg[2], v[j][3] * rs * gg[3]); o[64 * j] = w; }
    }
}
__device__ __forceinline__ void resnorm_rows(const float* hin, const bf16_t* tmp, const float* g1, float* hout, const float* g2, bf16_t* xn, int gw, int NGW, int lane) {
    for (int row = gw; row < NTOK; row += NGW) {
        const u32x2* tr = (const u32x2*)(tmp + (size_t)row * DMODEL) + lane; f32x4 t[4]; float ss = 0.f;
#pragma unroll
        for (int j = 0; j < 4; ++j) { const u32x2 w = tr[64 * j]; t[j] = (f32x4){bflo(w.x), bfhi(w.x), bflo(w.y), bfhi(w.y)}; ss += (t[j][0] * t[j][0] + t[j][1] * t[j][1]) + (t[j][2] * t[j][2] + t[j][3] * t[j][3]); }
        const float rs = __builtin_amdgcn_rsqf(wave_sum(ss) * (1.f / DMODEL) + EPSN);
        const f32x4* hr = (const f32x4*)(hin + (size_t)row * DMODEL) + lane; f32x4* ho = (f32x4*)(hout + (size_t)row * DMODEL) + lane; float s2 = 0.f;
#pragma unroll
        for (int j = 0; j < 4; ++j) { const f32x4 gg = ((const f32x4*)g1)[lane + 64 * j]; f32x4 h = hr[64 * j];
            h[0] += t[j][0] * rs * gg[0]; h[1] += t[j][1] * rs * gg[1]; h[2] += t[j][2] * rs * gg[2]; h[3] += t[j][3] * rs * gg[3];
            st16_wt(ho + 64 * j, __builtin_bit_cast(u32x4, h)); t[j] = h; s2 += (h[0] * h[0] + h[1] * h[1]) + (h[2] * h[2] + h[3] * h[3]); }
        if (g2) {
            const float r2 = __builtin_amdgcn_rsqf(wave_sum(s2) * (1.f / DMODEL) + EPSN);
            u32x2* o = (u32x2*)(xn + (size_t)row * DMODEL) + lane;
#pragma unroll
            for (int j = 0; j < 4; ++j) { const f32x4 gg = ((const f32x4*)g2)[lane + 64 * j]; u32x2 w; w.x = cvtpk(t[j][0] * r2 * gg[0], t[j][1] * r2 * gg[1]); w.y = cvtpk(t[j][2] * r2 * gg[2], t[j][3] * r2 * gg[3]); o[64 * j] = w; }
        }
    }
}
__device__ __forceinline__ void prep_rows(bf16_t* proj, const float* gq, const float* gk, const float* mq, const float* mkv, const float* rope, int gw, int NGW, int lane) {
    const int j = lane & 15; const bool up = (lane & 16) != 0;
    for (int row = gw; row < NTOK; row += NGW) {
        bf16_t* pr = proj + (size_t)row * LDP; const int l = row & (SEQL - 1); const int pos = (lane < 32) ? (l >> 6) : (l & 63);
        const f32x2 cs = *(const f32x2*)(rope + ((size_t)pos * 16 + j) * 2);
        float hv[10];
#pragma unroll
        for (int hh = 0; hh < 10; ++hh) hv[hh] = bf1(pr[(hh < 8 ? C_BQ + hh * 64 : C_BK + (hh - 8) * 64) + lane]);
        const float ggq = gq[lane], ggk = gk[lane];
#pragma unroll
        for (int hh = 0; hh < 10; ++hh) {
            const int base = hh < 8 ? C_BQ + hh * 64 : C_BK + (hh - 8) * 64; const float gg = hh < 8 ? ggq : ggk;
            float v = hv[hh]; const float ss = wave_sum(v * v);
            v = v * __builtin_amdgcn_rsqf(ss * (1.f / 64) + EPSN) * gg;
            const float pv = __shfl_xor(v, 16);
            const float o = up ? (pv * cs[1] + v * cs[0]) : (v * cs[0] - pv * cs[1]);
            pr[base + lane] = tobf(o);
        }
        {
            const u32x2 w = *(const u32x2*)(pr + C_CQ + 4 * lane); f32x4 v = {bflo(w.x), bfhi(w.x), bflo(w.y), bfhi(w.y)};
            const float rs = __builtin_amdgcn_rsqf(wave_sum((v[0] * v[0] + v[1] * v[1]) + (v[2] * v[2] + v[3] * v[3])) * (1.f / 256) + EPSN); const f32x4 gg = ((const f32x4*)mq)[lane];
            u32x2 o; o.x = cvtpk(v[0] * rs * gg[0], v[1] * rs * gg[1]); o.y = cvtpk(v[2] * rs * gg[2], v[3] * rs * gg[3]); *(u32x2*)(pr + C_CQ + 4 * lane) = o;
        }
        {
            const unsigned w = *(const unsigned*)(pr + C_CKV + 2 * lane); const float a = bflo(w), b = bfhi(w);
            const float rs = __builtin_amdgcn_rsqf(wave_sum(a * a + b * b) * (1.f / 128) + EPSN); const f32x2 gg = ((const f32x2*)mkv)[lane];
            *(unsigned*)(pr + C_CKV + 2 * lane) = cvtpk(a * rs * gg[0], b * rs * gg[1]);
        }
        {
            const float v = bf1(pr[C_CKR + (lane & 31)]); const float pv = __shfl_xor(v, 16);
            const f32x2 c2 = *(const f32x2*)(rope + ((size_t)l * 16 + j) * 2);
            const float o = up ? (pv * c2[1] + v * c2[0]) : (v * c2[0] - pv * c2[1]);
            if (lane < 32) pr[C_CKR + 2 * j + (lane >> 4)] = tobf(o);
        }
    }
}

struct S5Lane { float lbr, lbi; f32x2 bb[16]; };
__device__ __forceinline__ void s5_setup(PPtr P, int li, int dir, int g, int p, S5Lane& L) {
    const size_t ga = ((size_t)(li * 2 + dir) * 32 + g);
    const float are = fminf(P->in[18][ga * 64 + p], -1e-4f), aim = P->in[19][ga * 64 + p]; const float dt = expf(P->in[20][ga]);
    const float mag = expf(are * dt); float sn, cn; sincos_d((double)(aim * dt), sn, cn);
    L.lbr = mag * cn; L.lbi = mag * sn;
    const float den = are * are + aim * aim, nre = L.lbr - 1.f;
    const float fre = (nre * are + L.lbi * aim) / den, fim = (L.lbi * are - nre * aim) / den;
    const f32x4* br = (const f32x4*)(P->in[21] + (ga * 64 + p) * 16); const f32x4* bi = (const f32x4*)(P->in[22] + (ga * 64 + p) * 16);
#pragma unroll
    for (int q = 0; q < 4; ++q) { const f32x4 r = br[q], i = bi[q];
#pragma unroll
        for (int e = 0; e < 4; ++e) L.bb[4 * q + e] = (f32x2){fre * r[e] - fim * i[e], fre * i[e] + fim * r[e]}; }
}
__device__ __forceinline__ void s5_step(const S5Lane& L, const LAS unsigned char* urow, float& sr, float& si) {
    const u32x4 ua = *(const LAS u32x4*)urow, ub = *(const LAS u32x4*)(urow + 16);
    f32x2 x2;
#define S5_U2(v) ((f32x2){(v), (v)})
    x2 = S5_U2(bflo(ua.x)) * L.bb[0];
    x2 = __builtin_elementwise_fma(S5_U2(bfhi(ua.x)), L.bb[1], x2);
    x2 = __builtin_elementwise_fma(S5_U2(bflo(ua.y)), L.bb[2], x2);
    x2 = __builtin_elementwise_fma(S5_U2(bfhi(ua.y)), L.bb[3], x2);
    x2 = __builtin_elementwise_fma(S5_U2(bflo(ua.z)), L.bb[4], x2);
    x2 = __builtin_elementwise_fma(S5_U2(bfhi(ua.z)), L.bb[5], x2);
    x2 = __builtin_elementwise_fma(S5_U2(bflo(ua.w)), L.bb[6], x2);
    x2 = __builtin_elementwise_fma(S5_U2(bfhi(ua.w)), L.bb[7], x2);
    x2 = __builtin_elementwise_fma(S5_U2(bflo(ub.x)), L.bb[8], x2);
    x2 = __builtin_elementwise_fma(S5_U2(bfhi(ub.x)), L.bb[9], x2);
    x2 = __builtin_elementwise_fma(S5_U2(bflo(ub.y)), L.bb[10], x2);
    x2 = __builtin_elementwise_fma(S5_U2(bfhi(ub.y)), L.bb[11], x2);
    x2 = __builtin_elementwise_fma(S5_U2(bflo(ub.z)), L.bb[12], x2);
    x2 = __builtin_elementwise_fma(S5_U2(bfhi(ub.z)), L.bb[13], x2);
    x2 = __builtin_elementwise_fma(S5_U2(bflo(ub.w)), L.bb[14], x2);
    x2 = __builtin_elementwise_fma(S5_U2(bfhi(ub.w)), L.bb[15], x2);
#undef S5_U2
    const float xr = x2[0], xi = x2[1];
    const float nr = L.lbr * sr - L.lbi * si + xr, ni = L.lbr * si + L.lbi * sr + xi; sr = nr; si = ni;
}
__device__ __forceinline__ void s5_stage_u(const bf16_t* proj, int b, int g, int ch, LAS unsigned char* ulds, int lane) {
    const bf16_t* src = proj + ((size_t)b * SEQL + (size_t)ch * S5_CH) * LDP + C_DU + g * 16;
#pragma unroll
    for (int it = 0; it < 4; ++it) { const int r = it * 32 + (lane >> 1), hf = lane & 1; *(LAS u32x4*)(ulds + r * 32 + hf * 16) = *(const u32x4*)(src + (size_t)r * LDP + hf * 8); }
    asm volatile("s_waitcnt vmcnt(0) lgkmcnt(0)" ::: "memory");
}
__device__ __forceinline__ void s5_pass1(PPtr P, int li, LAS unsigned char* lds, int gw, int NGW, int wave, int lane) {
    LAS unsigned char* ulds = lds + wave * 16640; const bf16_t* proj = (const bf16_t*)(P->ws + OFF_PROJ); f32x2* carry = (f32x2*)(P->ws + OFF_CARRY);
    for (int item = gw; item < NBATCH * 32 * S5_NCH; item += NGW) {
        const int ch = item % S5_NCH, g = (item / S5_NCH) % 32, b = item / (S5_NCH * 32);
        s5_stage_u(proj, b, g, ch, ulds, lane);
#pragma unroll 1
        for (int dir = 0; dir < 2; ++dir) {
            S5Lane L; s5_setup(P, li, dir, g, lane, L); float sr = 0.f, si = 0.f;
#pragma unroll 2
            for (int jj = 0; jj < S5_CH; ++jj) { const int j = dir ? S5_CH - 1 - jj : jj; s5_step(L, ulds + j * 32, sr, si); }
            carry[((((size_t)b * 32 + g) * S5_NCH + ch) * 2 + dir) * 64 + lane] = (f32x2){sr, si};
        }
        asm volatile("s_waitcnt lgkmcnt(0)" ::: "memory");
    }
}
__device__ __forceinline__ void s5_pass2(PPtr P, int li, LAS unsigned char* lds, int gw, int NGW, int wave, int lane) {
    LAS unsigned char* ulds = lds + wave * 16640; LAS unsigned char* slds = ulds + 4096; LAS float* ylds = (LAS float*)(ulds + 4096 + 4352);
    bf16_t* proj = (bf16_t*)(P->ws + OFF_PROJ); const f32x2* carry = (const f32x2*)(P->ws + OFF_CARRY);
    const int hq = lane & 15, kq = lane >> 4;
    for (int item = gw; item < NBATCH * 32 * S5_NCH; item += NGW) {
        const int ch = item % S5_NCH, g = (item / S5_NCH) % 32, b = item / (S5_NCH * 32);
        s5_stage_u(proj, b, g, ch, ulds, lane);
#pragma unroll 1
        for (int dir = 0; dir < 2; ++dir) {
            S5Lane L; s5_setup(P, li, dir, g, lane, L);
            float cr = L.lbr, ci = L.lbi;
#pragma unroll
            for (int q = 0; q < 7; ++q) { const float nr = cr * cr - ci * ci, ni = 2.f * cr * ci; cr = nr; ci = ni; }
            float sr = 0.f, si = 0.f;
            const f32x2* cb = carry + ((((size_t)b * 32 + g) * S5_NCH) * 2 + dir) * 64 + lane;
            if (dir == 0) {
#pragma unroll 4
                for (int c = 0; c < ch; ++c) { const f32x2 e = cb[(size_t)c * 128]; const float nr = cr * sr - ci * si + e[0], ni = cr * si + ci * sr + e[1]; sr = nr; si = ni; } }
            else {
#pragma unroll 4
                for (int c = S5_NCH - 1; c > ch; --c) { const f32x2 e = cb[(size_t)c * 128]; const float nr = cr * sr - ci * si + e[0], ni = cr * si + ci * sr + e[1]; sr = nr; si = ni; } }
            bf16x8 bc[4];
            { const size_t cbase = (((size_t)(li * 2 + dir) * 32 + g) * 16 + hq) * 64;
#pragma unroll
              for (int ks = 0; ks < 4; ++ks) { const f32x4 re = *(const f32x4*)(P->in[23] + cbase + 16 * ks + 4 * kq), im = *(const f32x4*)(P->in[24] + cbase + 16 * ks + 4 * kq);
                  u32x4 w; w.x = cvtpk(re[0], -im[0]); w.y = cvtpk(re[1], -im[1]); w.z = cvtpk(re[2], -im[2]); w.w = cvtpk(re[3], -im[3]); bc[ks] = __builtin_bit_cast(bf16x8, w); } }
#pragma unroll 1
            for (int sb = 0; sb < S5_CH / 16; ++sb) {
                const int sub = dir ? S5_CH / 16 - 1 - sb : sb;
#pragma unroll 2
                for (int q = 0; q < 16; ++q) { const int jj = dir ? 15 - q : q; s5_step(L, ulds + (sub * 16 + jj) * 32, sr, si); *(LAS unsigned*)(slds + jj * 272 + lane * 4) = cvtpk(sr, si); }
                asm volatile("s_waitcnt lgkmcnt(0)" ::: "memory");
                f32x4 acc = {0.f, 0.f, 0.f, 0.f};
#pragma unroll
                for (int ks = 0; ks < 4; ++ks) { const bf16x8 a = *(const LAS bf16x8*)(slds + hq * 272 + ks * 64 + kq * 16); acc = __builtin_amdgcn_mfma_f32_16x16x32_bf16(a, bc[ks], acc, 0, 0, 0); }
                asm volatile("s_nop 15\n\ts_nop 15" : "+v"(acc));
                LAS float* yp = ylds + (sub * 16 + kq * 4) * 16 + hq;
                if (dir == 0) { yp[0] = acc[0]; yp[16] = acc[1]; yp[32] = acc[2]; yp[48] = acc[3]; }
                else { yp[0] += acc[0]; yp[16] += acc[1]; yp[32] += acc[2]; yp[48] += acc[3]; }
                asm volatile("s_waitcnt lgkmcnt(0)" ::: "memory");
            }
        }
        const float dd = P->in[25][((size_t)li * 32 + g) * 16 + hq];
        bf16_t* dst = proj + ((size_t)b * SEQL + (size_t)ch * S5_CH) * LDP + C_DU + g * 16 + hq;
#pragma unroll 4
        for (int it = 0; it < S5_CH / 4; ++it) { const int r = it * 4 + kq; const float uu = bf1(*(const LAS bf16_t*)(ulds + r * 32 + hq * 2)); const float y = ylds[r * 16 + hq] + dd * uu;
            const float z = 1.5957691216057308f * (y + 0.044715f * y * y * y); dst[(size_t)r * LDP] = tobf(y * fsigmoid(z)); }
        asm volatile("s_waitcnt lgkmcnt(0)" ::: "memory");
    }
}

constexpr int S5_XP = 132;
constexpr int S5_WLDS = 4096 + 16 * S5_XP * 4 + 16 * 272;
template <int DIR, bool PASS2>
__device__ __forceinline__ void s5_sub(LAS unsigned char* ulds, const bf16x8 (&bb)[8], const bf16x8 (&bc)[4], float lbr, float lbi, float& sr, float& si, f32x4& yacc, int sub, int lane) {
    LAS float* xlds = (LAS float*)(ulds + 4096); LAS unsigned char* slds = ulds + 4096 + 16 * S5_XP * 4;
    const int hq = lane & 15, kq = lane >> 4;
    u32x4 uw = {0u, 0u, 0u, 0u};
    if (kq < 2) uw = *(const LAS u32x4*)(ulds + (sub * 16 + hq) * 32 + kq * 16);
    const bf16x8 ua = __builtin_bit_cast(bf16x8, uw);
    LAS float* xp = xlds + (4 * kq) * S5_XP + hq;
    f32x4 xs[8];
#pragma unroll
    for (int nt = 0; nt < 8; ++nt) xs[nt] = __builtin_amdgcn_mfma_f32_16x16x32_bf16(ua, bb[nt], (f32x4){0.f, 0.f, 0.f, 0.f}, 0, 0, 0);
    asm volatile("s_nop 15\n\ts_nop 15" : "+v"(xs[0]), "+v"(xs[1]), "+v"(xs[2]), "+v"(xs[3]), "+v"(xs[4]), "+v"(xs[5]), "+v"(xs[6]), "+v"(xs[7]));
#pragma unroll
    for (int nt = 0; nt < 8; ++nt) { xp[16 * nt] = xs[nt][0]; xp[16 * nt + S5_XP] = xs[nt][1]; xp[16 * nt + 2 * S5_XP] = xs[nt][2]; xp[16 * nt + 3 * S5_XP] = xs[nt][3]; }
    asm volatile("s_waitcnt lgkmcnt(0)" ::: "memory");
    const LAS float* xr = xlds + 2 * lane; LAS unsigned char* sw = slds + lane * 4;
#pragma unroll
    for (int q = 0; q < 16; ++q) {
        const int jj = DIR ? 15 - q : q;
        const f32x2 x = *(const LAS f32x2*)(xr + jj * S5_XP);
        const float nr = lbr * sr - lbi * si + x[0], ni = lbr * si + lbi * sr + x[1]; sr = nr; si = ni;
        if (PASS2) *(LAS unsigned*)(sw + jj * 272) = cvtpk(sr, si);
    }
    if (PASS2) {
        asm volatile("s_waitcnt lgkmcnt(0)" ::: "memory");
        f32x4 acc = DIR ? yacc : (f32x4){0.f, 0.f, 0.f, 0.f};
        const LAS unsigned char* sa = slds + hq * 272 + kq * 16;
#pragma unroll
        for (int ks = 0; ks < 4; ++ks) { const bf16x8 a = *(const LAS bf16x8*)(sa + ks * 64); acc = __builtin_amdgcn_mfma_f32_16x16x32_bf16(a, bc[ks], acc, 0, 0, 0); }
        yacc = acc;
    }
    asm volatile("s_waitcnt lgkmcnt(0)" ::: "memory");
    __builtin_amdgcn_sched_barrier(0);
}
template <int DIR, bool PASS2>
__device__ __forceinline__ void s5_dir(LAS unsigned char* ulds, const bf16x8 (&bb)[8], const bf16x8 (&bc)[4], float lbr, float lbi, float& sr, float& si, f32x4 (&yacc)[8], int lane) {
    if constexpr (PASS2) {
#pragma unroll
        for (int sb = 0; sb < 8; ++sb) { const int sub = DIR ? 7 - sb : sb; s5_sub<DIR, true>(ulds, bb, bc, lbr, lbi, sr, si, yacc[sub], sub, lane); }
    } else {
#pragma unroll 1
        for (int sb = 0; sb < 8; ++sb) { const int sub = DIR ? 7 - sb : sb; s5_sub<DIR, false>(ulds, bb, bc, lbr, lbi, sr, si, yacc[0], sub, lane); }
    }
}

__device__ __forceinline__ void s5n_setup(PPtr P, int li, int dir, int g, int lane, float& lbr, float& lbi, bf16x8 (&bb)[8], LAS unsigned char* scr) {
    const size_t ga = ((size_t)(li * 2 + dir) * 32 + g);
    const float are = fminf(P->in[18][ga * 64 + lane], -1e-4f), aim = P->in[19][ga * 64 + lane]; const float dt = expf(P->in[20][ga]);
    const float mag = expf(are * dt); float sn, cn;
    { float xr_ = aim * dt * 0.15915494309189535f; xr_ -= __builtin_rintf(xr_); sn = __builtin_amdgcn_sinf(xr_); cn = __builtin_amdgcn_cosf(xr_); }
    lbr = mag * cn; lbi = mag * sn; const float den = are * are + aim * aim, nre = lbr - 1.f;
    const float fre = (nre * are + lbi * aim) / den, fim = (lbi * are - nre * aim) / den;
    const int hq = lane & 15, kq = lane >> 4, ri = lane & 1;
#pragma unroll 1
    for (int nt = 0; nt < 8; ++nt) {
        const int pp = 8 * nt + (hq >> 1); const float fr2 = __shfl(fre, pp), fi2 = __shfl(fim, pp);
        const int kq2 = kq & 1;
        const f32x4* br = (const f32x4*)(P->in[21] + (ga * 64 + pp) * 16 + 8 * kq2); const f32x4* bi = (const f32x4*)(P->in[22] + (ga * 64 + pp) * 16 + 8 * kq2);
        const f32x4 r0 = br[0], r1 = br[1], i0 = bi[0], i1 = bi[1]; float v[8];
#pragma unroll
        for (int e = 0; e < 4; ++e) { v[e] = ri ? (fr2 * i0[e] + fi2 * r0[e]) : (fr2 * r0[e] - fi2 * i0[e]); v[4 + e] = ri ? (fr2 * i1[e] + fi2 * r1[e]) : (fr2 * r1[e] - fi2 * i1[e]); }
        u32x4 w; w.x = cvtpk(v[0], v[1]); w.y = cvtpk(v[2], v[3]); w.z = cvtpk(v[4], v[5]); w.w = cvtpk(v[6], v[7]);
        if (kq >= 2) w = (u32x4){0u, 0u, 0u, 0u};
        *(LAS u32x4*)(scr + (nt * 64 + lane) * 16) = w;
    }
    asm volatile("s_waitcnt lgkmcnt(0)" ::: "memory");
#pragma unroll
    for (int nt = 0; nt < 8; ++nt) bb[nt] = *(const LAS bf16x8*)(scr + (nt * 64 + lane) * 16);
    asm volatile("s_waitcnt lgkmcnt(0)" ::: "memory");
}
__device__ __forceinline__ void s5n_stage_u(const bf16_t* proj, int b, int g, int ch, LAS unsigned char* ulds, int lane) {
    const bf16_t* src = proj + ((size_t)b * SEQL + (size_t)ch * S5_CH) * LDP + C_DU + g * 16;
#pragma unroll
    for (int it = 0; it < 4; ++it) { const int r = it * 32 + (lane >> 1), hf = lane & 1; *(LAS u32x4*)(ulds + r * 32 + hf * 16) = *(const u32x4*)(src + (size_t)r * LDP + hf * 8); }
    asm volatile("s_waitcnt vmcnt(0) lgkmcnt(0)" ::: "memory");
}
__device__ __forceinline__ void s5n_pass1(PPtr P, int li, LAS unsigned char* lds, int gw, int NGW, int wave, int lane) {
    LAS unsigned char* ulds = lds + wave * S5_WLDS; const bf16_t* proj = (const bf16_t*)(P->ws + OFF_PROJ); f32x2* carry = (f32x2*)(P->ws + OFF_CARRY);
    for (int item = gw; item < NBATCH * 32 * S5_NCH; item += NGW) {
        const int ch = item % S5_NCH, g = (item / S5_NCH) % 32, b = item / (S5_NCH * 32);
        s5n_stage_u(proj, b, g, ch, ulds, lane);
#pragma unroll 1
        for (int dir = 0; dir < 2; ++dir) {
            float lbr, lbi; bf16x8 bb[8], bc[4]; f32x4 ydummy[8];
            s5n_setup(P, li, dir, g, lane, lbr, lbi, bb, ulds + 4096);
            float sr = 0.f, si = 0.f;
            if (dir == 0) s5_dir<0, false>(ulds, bb, bc, lbr, lbi, sr, si, ydummy, lane); else s5_dir<1, false>(ulds, bb, bc, lbr, lbi, sr, si, ydummy, lane);
            carry[((((size_t)b * 32 + g) * S5_NCH + ch) * 2 + dir) * 64 + lane] = (f32x2){sr, si};
        }
    }
}

template <int DIR> __device__ __forceinline__ void s5_carry_in(const f32x2* cb, int ch, float lbr, float lbi, float& sr, float& si) {
    float cr = lbr, ci = lbi;
#pragma unroll
    for (int q = 0; q < 7; ++q) { const float nr = cr * cr - ci * ci, ni = 2.f * cr * ci; cr = nr; ci = ni; }
    sr = 0.f; si = 0.f;
    if (DIR == 0) {
#pragma unroll 4
        for (int c = 0; c < ch; ++c) { const f32x2 e = cb[(size_t)c * 128]; const float nr = cr * sr - ci * si + e[0], ni = cr * si + ci * sr + e[1]; sr = nr; si = ni; }
    } else {
#pragma unroll 4
        for (int c = S5_NCH - 1; c > ch; --c) { const f32x2 e = cb[(size_t)c * 128]; const float nr = cr * sr - ci * si + e[0], ni = cr * si + ci * sr + e[1]; sr = nr; si = ni; }
    }
}
__device__ __forceinline__ void s5h_pass2(PPtr P, int li, LAS unsigned char* lds, int gw, int NGW, int wave, int lane) {
    LAS unsigned char* ulds = lds + wave * S5_WLDS; bf16_t* proj = (bf16_t*)(P->ws + OFF_PROJ); const f32x2* carry = (const f32x2*)(P->ws + OFF_CARRY);
    const int hq = lane & 15, kq = lane >> 4;
    for (int item = gw; item < NBATCH * 32 * S5_NCH; item += NGW) {
        const int ch = item % S5_NCH, g = (item / S5_NCH) % 32, b = item / (S5_NCH * 32);
        s5n_stage_u(proj, b, g, ch, ulds, lane);
        bf16_t* dst = proj + ((size_t)b * SEQL + (size_t)ch * S5_CH) * LDP + C_DU + g * 16 + hq;
        const float dd = P->in[25][((size_t)li * 32 + g) * 16 + hq];
#pragma unroll 1
        for (int dir = 0; dir < 2; ++dir) {
            float lbr, lbi; bf16x8 bb[8], bc[4];
            s5n_setup(P, li, dir, g, lane, lbr, lbi, bb, ulds + 4096);
            { const size_t cbase = (((size_t)(li * 2 + dir) * 32 + g) * 16 + hq) * 64;
#pragma unroll
              for (int ks = 0; ks < 4; ++ks) { const f32x4 re = *(const f32x4*)(P->in[23] + cbase + 16 * ks + 4 * kq), im = *(const f32x4*)(P->in[24] + cbase + 16 * ks + 4 * kq);
                  u32x4 w; w.x = cvtpk(re[0], -im[0]); w.y = cvtpk(re[1], -im[1]); w.z = cvtpk(re[2], -im[2]); w.w = cvtpk(re[3], -im[3]); bc[ks] = __builtin_bit_cast(bf16x8, w); } }
            float sr, si;
            const f32x2* cb = carry + ((((size_t)b * 32 + g) * S5_NCH) * 2 + dir) * 64 + lane;
            if (dir == 0) s5_carry_in<0>(cb, ch, lbr, lbi, sr, si); else s5_carry_in<1>(cb, ch, lbr, lbi, sr, si);
#pragma unroll 1
            for (int sb = 0; sb < 8; ++sb) {
                const int sub = dir ? 7 - sb : sb;
                bf16_t* drow = dst + (size_t)(sub * 16 + 4 * kq) * LDP;
                float yf[4] = {0.f, 0.f, 0.f, 0.f};
                if (dir) {
#pragma unroll
                    for (int i = 0; i < 4; ++i) yf[i] = bf1(drow[(size_t)i * LDP]);
                }
                f32x4 acc = {0.f, 0.f, 0.f, 0.f};
                if (dir == 0) s5_sub<0, true>(ulds, bb, bc, lbr, lbi, sr, si, acc, sub, lane); else s5_sub<1, true>(ulds, bb, bc, lbr, lbi, sr, si, acc, sub, lane);
                if (dir == 0) {
#pragma unroll
                    for (int i = 0; i < 4; ++i) drow[(size_t)i * LDP] = tobf(acc[i]);
                } else {
#pragma unroll
                    for (int i = 0; i < 4; ++i) { const int r = sub * 16 + 4 * kq + i; const float uu = bf1(*(const LAS bf16_t*)(ulds + r * 32 + hq * 2)); const float y = acc[i] + yf[i] + dd * uu;
                        const float z = 1.5957691216057308f * (y + 0.044715f * y * y * y); drow[(size_t)i * LDP] = tobf(y * fsigmoid(z)); }
                }
            }
        }
        asm volatile("s_waitcnt vmcnt(0) lgkmcnt(0)" ::: "memory");
    }
}

typedef short v4i16_t __attribute__((ext_vector_type(4)));
__device__ __forceinline__ float other_half(float v) { unsigned a = __builtin_bit_cast(unsigned, v), b = a; asm volatile("" : "+v"(b)); auto rr = __builtin_amdgcn_permlane32_swap(a, b, false, false);
    const float x = __builtin_bit_cast(float, rr[0]), y = __builtin_bit_cast(float, rr[1]); return (threadIdx.x & 32) ? x : y; }
__device__ __forceinline__ float max3f(float a, float b, float c) { float r; asm("v_max3_f32 %0, %1, %2, %3" : "=v"(r) : "v"(a), "v"(b), "v"(c)); return r; }
__device__ __forceinline__ bf16x8 scale_frag(bf16x8 f, float c) { const u32x4 w = __builtin_bit_cast(u32x4, f); u32x4 o;
    o.x = cvtpk(bflo(w.x) * c, bfhi(w.x) * c); o.y = cvtpk(bflo(w.y) * c, bfhi(w.y) * c); o.z = cvtpk(bflo(w.z) * c, bfhi(w.z) * c); o.w = cvtpk(bflo(w.w) * c, bfhi(w.w) * c); return __builtin_bit_cast(bf16x8, o); }
template <int DQK, int DV, bool BIAS>
__device__ __forceinline__ void attn_pass(LAS unsigned char* lds, const bf16_t* Qw, int ldq, const bf16_t* Q2w, int ldq2, const bf16_t* Kg, int ldk, const bf16_t* K2g, int ldk2,
                                          const bf16_t* Vg, int ldv, int qpos0, float cs, float sl2, const float* ropetab, f32x16 (&o)[DV / 32]) {
    constexpr int KP = DQK * 2 + 16, KBUF = 64 * KP, VBUF = (DV / 32) * 4096, NKS = DQK / 16, NDT = DV / 32, NVL = DV / 64, VOFF = ((DV == 64) ? 4 : 2) * KBUF;
    int tid_ = threadIdx.x; asm volatile("" : "+v"(tid_));
    const int tid = tid_, lane = tid & 63, r32 = lane & 31, hi = lane >> 5;
    const bool isY = false;
    bf16x8 qf[NKS];
#pragma unroll
    for (int ks = 0; ks < NKS; ++ks) qf[ks] = ks < 4 ? *(const bf16x8*)(Qw + (size_t)r32 * ldq + ks * 16 + hi * 8) : *(const bf16x8*)(Q2w + (size_t)r32 * ldq2 + (ks - 4) * 16 + hi * 8);
#pragma unroll
    for (int ks = 0; ks < 4; ++ks) qf[ks] = scale_frag(qf[ks], cs);
    if constexpr (DQK == 96) {
        const float* rp = ropetab + ((size_t)(qpos0 + r32) * 16) * 2;
#pragma unroll
        for (int ks = 4; ks < 6; ++ks) {
            const f32x4 c0 = *(const f32x4*)(rp + ((ks - 4) * 8 + hi * 4) * 2), c1 = *(const f32x4*)(rp + ((ks - 4) * 8 + hi * 4 + 2) * 2);
            const u32x4 w = __builtin_bit_cast(u32x4, qf[ks]); u32x4 ow;
            { const float a = bflo(w.x) * cs, b = bfhi(w.x) * cs; ow.x = cvtpk(a * c0[0] - b * c0[1], a * c0[1] + b * c0[0]); }
            { const float a = bflo(w.y) * cs, b = bfhi(w.y) * cs; ow.y = cvtpk(a * c0[2] - b * c0[3], a * c0[3] + b * c0[2]); }
            { const float a = bflo(w.z) * cs, b = bfhi(w.z) * cs; ow.z = cvtpk(a * c1[0] - b * c1[1], a * c1[1] + b * c1[0]); }
            { const float a = bflo(w.w) * cs, b = bfhi(w.w) * cs; ow.w = cvtpk(a * c1[2] - b * c1[3], a * c1[3] + b * c1[2]); }
            qf[ks] = __builtin_bit_cast(bf16x8, ow);
        }
    }
#pragma unroll
    for (int d = 0; d < NDT; ++d)
#pragma unroll
        for (int r = 0; r < 16; ++r) o[d][r] = 0.f;
#pragma unroll
    for (int ks = 0; ks < NKS; ++ks) asm volatile("" : "+v"(qf[ks]));
    float mhat = 0.f, l = 0.f; f32x16 negm;
#pragma unroll
    for (int r = 0; r < 16; ++r) negm[r] = 0.f;
    constexpr int TPB = (DV == 64) ? 2 : 1, NG = SEQL / 64 / TPB;
    u32x4 kreg[TPB], k2reg[TPB], vreg[TPB][NVL];
    const bf16_t* kptr = Kg + (size_t)(tid >> 3) * ldk + (tid & 7) * 8;
    const bf16_t* k2ptr = (DQK == 96) ? K2g + (size_t)(tid >> 2) * ldk2 + (tid & 3) * 8 : nullptr;
#define ATT_LOAD(t, j_) do { kreg[j_] = *(const u32x4*)(kptr + (size_t)(t) * 64 * ldk); \
        if (DQK == 96) { if (tid < 256) k2reg[j_] = *(const u32x4*)(k2ptr + (size_t)(t) * 64 * ldk2); } \
        _Pragma("unroll") for (int i_ = 0; i_ < NVL; ++i_) { const int idx_ = tid + 512 * i_; vreg[j_][i_] = *(const u32x4*)(Vg + (size_t)((t) * 64 + ((idx_ & 255) >> 2)) * ldv + (idx_ >> 8) * 32 + (idx_ & 3) * 8); } } while (0)
#define ATT_STORE(sl_, j_) do { *(LAS u32x4*)(lds + (sl_) * KBUF + (tid >> 3) * KP + (tid & 7) * 16) = kreg[j_]; \
        if (DQK == 96) { if (tid < 256) *(LAS u32x4*)(lds + (sl_) * KBUF + (tid >> 2) * KP + 128 + (tid & 3) * 16) = k2reg[j_]; } \
        _Pragma("unroll") for (int i_ = 0; i_ < NVL; ++i_) { const int idx_ = tid + 512 * i_; *(LAS u32x4*)(lds + VOFF + (sl_) * VBUF + (idx_ >> 8) * 4096 + ((idx_ & 255) >> 2) * 64 + (idx_ & 3) * 16) = vreg[j_][i_]; } } while (0)
    u32x4 pw[4];
#pragma unroll
    for (int j = 0; j < TPB; ++j) { ATT_LOAD(j, j); ATT_STORE(j, j); }
#pragma unroll
    for (int j = 0; j < TPB; ++j) ATT_LOAD(TPB + j, j);
    const float qp = (float)(qpos0 + r32);
#pragma unroll 2
    for (int g = 0; g < NG; ++g) {
        const int pair = g & 1;
        __syncthreads();
        if (g + 1 < NG) {
#pragma unroll
            for (int j = 0; j < TPB; ++j) ATT_STORE((pair ^ 1) * TPB + j, j);
            if (g + 2 < NG) {
#pragma unroll
                for (int j = 0; j < TPB; ++j) ATT_LOAD((g + 2) * TPB + j, j);
            }
        }
#pragma unroll
      for (int sub = 0; sub < TPB; ++sub) {
        const int t = g * TPB + sub, buf = pair * TPB + sub, vcur = buf;
        f32x16 p0, p1;
        const LAS unsigned char* kb = lds + buf * KBUF + r32 * KP + hi * 16;
#pragma unroll
        for (int ks = 0; ks < NKS; ++ks) {
            const bf16x8 k0 = *(const LAS bf16x8*)(kb + ks * 32), k1 = *(const LAS bf16x8*)(kb + 32 * KP + ks * 32);
            if (ks == 0) { p0 = __builtin_amdgcn_mfma_f32_32x32x16_bf16(k0, qf[0], negm, 0, 0, 0); p1 = __builtin_amdgcn_mfma_f32_32x32x16_bf16(k1, qf[0], negm, 0, 0, 0); }
            else { p0 = __builtin_amdgcn_mfma_f32_32x32x16_bf16(k0, qf[ks], p0, 0, 0, 0); p1 = __builtin_amdgcn_mfma_f32_32x32x16_bf16(k1, qf[ks], p1, 0, 0, 0); }
        }
        if (BIAS) {
            asm volatile("s_nop 15\n\ts_nop 7" : "+v"(p0), "+v"(p1));
            const float d0 = qp - (float)(t * 64 + 4 * hi);
#pragma unroll
            for (int r = 0; r < 16; ++r) { const float dk = d0 - (float)((r & 3) + 8 * (r >> 2)); p0[r] = p0[r] - sl2 * fabsf(dk); p1[r] = p1[r] - sl2 * fabsf(dk - 32.f); }
        } else {
            asm volatile("s_nop 15\n\ts_nop 7" : "+v"(p0), "+v"(p1));
        }
        float mxa = max3f(p0[0], p0[1], p1[0]), mxb = max3f(p0[2], p0[3], p1[1]); mxa = max3f(mxa, p1[2], p1[3]);
#pragma unroll
        for (int r = 4; r < 16; r += 4) { mxa = max3f(mxa, p0[r], p0[r + 1]); mxb = max3f(mxb, p0[r + 2], p0[r + 3]); mxa = max3f(mxa, p1[r], p1[r + 1]); mxb = max3f(mxb, p1[r + 2], p1[r + 3]); }
        float mx = fmaxf(mxa, mxb);
        if (__any(mx > 8.f)) {
            mx = fmaxf(mx, __shfl_xor(mx, 32));
            const float dl = fmaxf(mx, 0.f); mhat += dl;
            const float f = __builtin_amdgcn_exp2f(-dl);
#pragma unroll
            for (int r = 0; r < 16; ++r) { p0[r] -= dl; p1[r] -= dl; negm[r] = -mhat; }
            l *= f;
#pragma unroll
            for (int d = 0; d < NDT; ++d)
#pragma unroll
                for (int r = 0; r < 16; ++r) o[d][r] *= f;
        }
        if (!isY) {
            const LAS unsigned char* vbase = lds + VOFF + vcur * VBUF + (4 * hi + ((lane & 15) >> 2)) * 64 + ((lane >> 4) & 1) * 32 + (lane & 3) * 8;
            float ls = 0.f;
#pragma unroll
            for (int hs = 0; hs < 4; ++hs) {
                float e[8];
#pragma unroll
                for (int j = 0; j < 8; ++j) { e[j] = __builtin_amdgcn_exp2f(hs < 2 ? p0[8 * (hs & 1) + j] : p1[8 * (hs & 1) + j]); ls += e[j]; }
                pw[hs].x = cvtpk(e[0], e[1]); pw[hs].y = cvtpk(e[2], e[3]); pw[hs].z = cvtpk(e[4], e[5]); pw[hs].w = cvtpk(e[6], e[7]);
                const bf16x8 pbv = __builtin_bit_cast(bf16x8, pw[hs]);
#pragma unroll
                for (int d = 0; d < NDT; ++d) { const LAS unsigned char* vp = vbase + d * 4096 + hs * 1024;
                    const v4i16_t a0 = __builtin_amdgcn_ds_read_tr16_b64_v4i16((LAS v4i16_t*)vp), a1 = __builtin_amdgcn_ds_read_tr16_b64_v4i16((LAS v4i16_t*)(vp + 512));
                    const bf16x8 av = {a0[0], a0[1], a0[2], a0[3], a1[0], a1[1], a1[2], a1[3]};
                    o[d] = __builtin_amdgcn_mfma_f32_32x32x16_bf16(av, pbv, o[d], 0, 0, 0); }
                __builtin_amdgcn_sched_barrier(0);
            }
            l += ls;
        } else {
            float ls = 0.f;
#pragma unroll
            for (int r = 0; r < 16; ++r) { p0[r] = __builtin_amdgcn_exp2f(p0[r]); p1[r] = __builtin_amdgcn_exp2f(p1[r]); ls += p0[r] + p1[r]; }
            l += ls;
#pragma unroll
            for (int s = 0; s < 2; ++s) {
                pw[s].x = cvtpk(p0[8 * s + 0], p0[8 * s + 1]); pw[s].y = cvtpk(p0[8 * s + 2], p0[8 * s + 3]); pw[s].z = cvtpk(p0[8 * s + 4], p0[8 * s + 5]); pw[s].w = cvtpk(p0[8 * s + 6], p0[8 * s + 7]);
                pw[2 + s].x = cvtpk(p1[8 * s + 0], p1[8 * s + 1]); pw[2 + s].y = cvtpk(p1[8 * s + 2], p1[8 * s + 3]); pw[2 + s].z = cvtpk(p1[8 * s + 4], p1[8 * s + 5]); pw[2 + s].w = cvtpk(p1[8 * s + 6], p1[8 * s + 7]);
            }
        }
      }
    }
    __syncthreads();
#undef ATT_LOAD
#undef ATT_STORE
#undef ATT_PV
    l += __shfl_xor(l, 32);
    const float inv = 1.f / l;
#pragma unroll
    for (int d = 0; d < NDT; ++d)
#pragma unroll
        for (int r = 0; r < 16; ++r) o[d][r] *= inv;
}
template <int NDT> __device__ __forceinline__ void attn_store(const f32x16 (&o)[NDT], bf16_t* Ow, int ldo, int r32, int hi) {
#pragma unroll
    for (int d = 0; d < NDT; ++d)
#pragma unroll
        for (int q = 0; q < 4; ++q) { u32x2 w; w.x = cvtpk(o[d][4 * q], o[d][4 * q + 1]); w.y = cvtpk(o[d][4 * q + 2], o[d][4 * q + 3]); *(u32x2*)(Ow + (size_t)r32 * ldo + 32 * d + 8 * q + 4 * hi) = w; }
}
__device__ __forceinline__ void attn_phase(PPtr P, int li, LAS unsigned char* lds, int vcu, int wave, int lane) {
    bf16_t* proj = (bf16_t*)(P->ws + OFF_PROJ); bf16_t* mlaq = (bf16_t*)(P->ws + OFF_MLAQ); const bf16_t* mlakv = (const bf16_t*)(P->ws + OFF_MLAKV);
    const int r32 = lane & 31, hi = lane >> 5;
    {
        const int b = vcu >> 6, h = (vcu >> 4) & 3, qb = vcu & 15;
        const size_t seq0 = (size_t)b * SEQL, qrow = seq0 + qb * 256 + wave * 32;
        const float slope = __builtin_amdgcn_exp2f(-2.f * (float)(h + 1));
        f32x16 o1[4], o2[4];
        attn_pass<64, 128, true>(lds, proj + qrow * LDP + C_AQ + h * 128, LDP, nullptr, 0, proj + seq0 * LDP + C_AK + h * 128, LDP, nullptr, 0, proj + seq0 * LDP + C_AV + h * 128, LDP, qb * 256 + wave * 32, 0.125f * LOG2E, slope * LOG2E, nullptr, o1);
        LAS unsigned* o1s = (LAS unsigned*)(lds + 81920 + wave * 8192) + lane;
#pragma unroll
        for (int d = 0; d < 4; ++d)
#pragma unroll
            for (int r = 0; r < 8; ++r) o1s[(d * 8 + r) * 64] = cvtpk(o1[d][2 * r], o1[d][2 * r + 1]);
        attn_pass<64, 128, true>(lds, proj + qrow * LDP + C_AQ + h * 128 + 64, LDP, nullptr, 0, proj + seq0 * LDP + C_AK + h * 128 + 64, LDP, nullptr, 0, proj + seq0 * LDP + C_AV + h * 128, LDP, qb * 256 + wave * 32, 0.125f * LOG2E, slope * LOG2E, nullptr, o2);
        const float s1 = wave_sum(P->in[7][li * 64 + lane] * P->in[8][li * 64 + lane]), s2 = wave_sum(P->in[9][li * 64 + lane] * P->in[10][li * 64 + lane]);
        const float lam_init = 0.8f - 0.6f * expf(-0.3f * (float)li); const float lam = expf(s1) - expf(s2) + lam_init;
        float ss = 0.f;
#pragma unroll
        for (int d = 0; d < 4; ++d)
#pragma unroll
            for (int r = 0; r < 8; ++r) { const unsigned w = o1s[(d * 8 + r) * 64]; const float v0 = bflo(w) - lam * o2[d][2 * r], v1 = bfhi(w) - lam * o2[d][2 * r + 1]; o1[d][2 * r] = v0; o1[d][2 * r + 1] = v1; ss += v0 * v0 + v1 * v1; }
        ss += __shfl_xor(ss, 32);
        const float rs = __builtin_amdgcn_rsqf(ss * (1.f / 128) + EPSN) * (1.f - lam_init);
        const float* sub = P->in[11] + li * 128;
#pragma unroll
        for (int d = 0; d < 4; ++d)
#pragma unroll
            for (int q = 0; q < 4; ++q) { const f32x4 gg = *(const f32x4*)(sub + 32 * d + 8 * q + 4 * hi);
                o1[d][4 * q] *= rs * gg[0]; o1[d][4 * q + 1] *= rs * gg[1]; o1[d][4 * q + 2] *= rs * gg[2]; o1[d][4 * q + 3] *= rs * gg[3]; }
        attn_store<4>(o1, proj + qrow * LDP + C_AQ + h * 128, LDP, r32, hi);
    }
#pragma unroll 1
    for (int k = 0; k < 2; ++k) {
        const int idx = vcu + 256 * k; const int b = idx >> 7, qh = (idx >> 4) & 7, qb = idx & 15, kvh = qh >> 2;
        const size_t seq0 = (size_t)b * SEQL, qrow = seq0 + qb * 256 + wave * 32;
        f32x16 o[2];
        attn_pass<64, 64, false>(lds, proj + qrow * LDP + C_BQ + qh * 64, LDP, nullptr, 0, proj + seq0 * LDP + C_BK + kvh * 64, LDP, nullptr, 0, proj + seq0 * LDP + C_BV + kvh * 64, LDP, 0, 0.125f * LOG2E, 0.f, nullptr, o);
        attn_store<2>(o, proj + qrow * LDP + C_BQ + qh * 64, LDP, r32, hi);
    }
#pragma unroll 1
    for (int k = 0; k < 2; ++k) {
        const int idx = vcu + 256 * k; const int b = idx >> 7, h = (idx >> 4) & 7, qb = idx & 15;
        const size_t seq0 = (size_t)b * SEQL, qrow = seq0 + qb * 256 + wave * 32;
        f32x16 o[2];
        attn_pass<96, 64, false>(lds, mlaq + qrow * 768 + h * 64, 768, mlaq + qrow * 768 + 512 + h * 32, 768, mlakv + seq0 * 1024 + h * 128, 1024, proj + seq0 * LDP + C_CKR, LDP,
                                 mlakv + seq0 * 1024 + h * 128 + 64, 1024, qb * 256 + wave * 32, 0.10206207261596575f * LOG2E, 0.f, (const float*)(P->ws + OFF_ROPE), o);
        attn_store<2>(o, mlaq + qrow * 768 + h * 64, 768, r32, hi);
    }
}

#define XB_TMO      128
#define XB_XCNT(j)  (256  + 64 * (j))
#define XB_XSUB(j)  (1280 + 64 * (j))
#define XB_XGEN(j)  (2304 + 64 * (j))
#define XB_TOP      3328
#define XB_TOPGEN   3392
#define XCD_BAR_WORDS 3456
#define XB_SPIN_CAP (1u << 18)

__device__ __forceinline__ unsigned xb_ld(unsigned* p)              { return __hip_atomic_load(p, __ATOMIC_RELAXED, __HIP_MEMORY_SCOPE_AGENT); }
__device__ __forceinline__ unsigned xb_add(unsigned* p, unsigned v) { return __hip_atomic_fetch_add(p, v, __ATOMIC_RELAXED, __HIP_MEMORY_SCOPE_AGENT); }
__device__ __forceinline__ unsigned xb_xcc_id() { return (unsigned)__builtin_amdgcn_s_getreg((3 << 11) | 20) & 0xFu; }
#define XB_SPIN(cond, bar) do { unsigned _sp = 0; while (cond) { \
    if ((++_sp & 255u) == 0u) { if (xb_ld(&(bar)[XB_TMO])) break; if (_sp > XB_SPIN_CAP) { atomicAdd(&(bar)[XB_TMO], 1u); break; } } } } while (0)

struct XcdBarrier {
    unsigned* bar; unsigned x;
    volatile LAS unsigned* st;
};

__device__ __forceinline__ XcdBarrier xcd_barrier_post(unsigned* bar, volatile LAS unsigned* st) {
    XcdBarrier b; b.bar = bar; b.x = xb_xcc_id(); b.st = st;
    if (threadIdx.x == 0) (void)xb_add(&bar[XB_XCNT(b.x)], 1u);
    return b;
}
__device__ __forceinline__ void xcd_barrier_complete(unsigned* bar, unsigned x, unsigned& nloc, unsigned& nx) {
    const unsigned G = gridDim.x * gridDim.y * gridDim.z;
    unsigned sum, cnt, mine, sp = 0u;
    for (;;) {
        sum = 0u; cnt = 0u; mine = 0u;
#pragma unroll
        for (unsigned j = 0; j < 16; ++j) { const unsigned c = xb_ld(&bar[XB_XCNT(j)]); sum += c; cnt += (c > 0u) ? 1u : 0u; mine = (j == x) ? c : mine; }
        if (sum == G) break;
        __builtin_amdgcn_s_sleep(1);
        if ((++sp & 255u) == 0u) { if (xb_ld(&bar[XB_TMO])) break; if (sp > XB_SPIN_CAP) { atomicAdd(&bar[XB_TMO], 1u); break; } }
    }
    nloc = mine > 0u ? mine : 1u; nx = cnt > 0u ? cnt : 1u;
}

__device__ __forceinline__ void xcd_barrier(const XcdBarrier& b) {
    asm volatile("s_waitcnt vmcnt(0)" ::: "memory");
    __syncthreads();
    if (threadIdx.x == 0) {
        unsigned* bar = b.bar;
        __builtin_amdgcn_s_waitcnt(0);
        unsigned nloc = b.st[0], nx = b.st[1];
        if (nloc == 0u) { xcd_barrier_complete(bar, b.x, nloc, nx); b.st[0] = nloc; b.st[1] = nx; }
        const unsigned old = xb_add(&bar[XB_XSUB(b.x)], 1u);
        const unsigned gen = old / nloc;
        if (old + 1u == (gen + 1u) * nloc) {
            __builtin_amdgcn_fence(__ATOMIC_RELEASE, "agent");
            asm volatile("s_waitcnt vmcnt(0)" ::: "memory");
            const unsigned og = xb_add(&bar[XB_TOP], 1u);
            const unsigned tg = og / nx;
            if (og + 1u == (tg + 1u) * nx) xb_add(&bar[XB_TOPGEN], 1u);
            else XB_SPIN(xb_ld(&bar[XB_TOPGEN]) == tg, bar);
            __builtin_amdgcn_fence(__ATOMIC_ACQUIRE, "agent");
            xb_add(&bar[XB_XGEN(b.x)], 1u);
            asm volatile("s_waitcnt vmcnt(0)" ::: "memory");
        } else {
            XB_SPIN(xb_ld(&bar[XB_XGEN(b.x)]) == gen, bar);
            __builtin_amdgcn_fence(__ATOMIC_ACQUIRE, "agent");
            asm volatile("s_waitcnt vmcnt(0)" ::: "memory");
        }
    }
    __syncthreads();
}

template <int ph> __device__ __forceinline__ void phase_body(LAS unsigned char* lds, int vcu, int NGW) {
        PPtr P = (PPtr)__builtin_amdgcn_kernarg_segment_ptr(); asm volatile("" : "+s"(P));
        bf16_t* proj = (bf16_t*)(P->ws + OFF_PROJ); bf16_t* mlaq = (bf16_t*)(P->ws + OFF_MLAQ); bf16_t* mlakv = (bf16_t*)(P->ws + OFF_MLAKV); bf16_t* xn = (bf16_t*)(P->ws + OFF_XN); bf16_t* yd = (bf16_t*)(P->ws + OFF_YD);
        const bf16_t* Wb = (const bf16_t*)(P->ws + OFF_W); float* rope = (float*)(P->ws + OFF_ROPE);
        bf16_t* hid = proj; bf16_t* mixed = mlakv; bf16_t* tmp1 = proj; bf16_t* tmp2 = xn; bf16_t* gatebuf = proj + C_AK;
        int tid_ = threadIdx.x; asm volatile("" : "+v"(tid_));
        const int lane = tid_ & 63, wave = __builtin_amdgcn_readfirstlane(tid_ >> 6), gw = vcu * 8 + wave;
        if constexpr (ph == 0) { if (PHON(0)) {
            const float invf[16] = {1.0f, 0.5623413324356079f, 0.3162277638912201f, 0.17782793939113617f, 0.10000000149011612f, 0.05623413249850273f, 0.03162277489900589f, 0.017782794311642647f,
                                    0.009999999776482582f, 0.005623413249850273f, 0.003162277629598975f, 0.0017782794311642647f, 0.0010000000474974513f, 0.000562341301701963f, 0.0003162277571391314f, 0.00017782794020604342f};
            for (int i = gw * 64 + lane; i < SEQL * 16; i += NGW * 64) {
                const int j = i & 15; float fv = invf[0];
#pragma unroll
                for (int q = 1; q < 16; ++q) fv = (j == q) ? invf[q] : fv;
                const float ang = (float)(i >> 4) * fv; float s, c; sincos_d((double)ang, s, c); rope[2 * i] = c; rope[2 * i + 1] = s;
            }
            convert_weights(P, 0, lds, gw, NGW, wave, lane);
            prenorm_rows(P->in[0], P->in[1], xn, gw, NGW, lane); }
        } else {
            constexpr int li = (ph - 1) / 10, k = (ph - 1) % 10 + 1;
            if constexpr (k == 1) { if (PHON(1)) {
                EpiB<0> E{proj, LDP, LDP, nullptr, 0, nullptr};
                run_gemm<0>(lds, xn, 1024, Wb + W_IN, 1024, NTOK, NPAD_IN, 1024, E);
            } } else if constexpr (k == 2) { if (PHON(2)) {
                prep_rows(proj, P->in[12] + li * 64, P->in[13] + li * 64, P->in[14] + li * 256, P->in[15] + li * 128, rope, gw, NGW, lane);
                s5n_pass1(P, li, lds, gw, NGW, wave, lane);
            } } else if constexpr (k == 3) { if (PHON(3)) {
#ifndef NO_G3
                { EpiB<0> E{mlaq, 768, 768, nullptr, 0, nullptr}; run_gemm<0>(lds, proj + C_CQ, LDP, Wb + W_UQ, 256, NTOK, 768, 256, E); }
                { EpiB<0> E{mlakv, 1024, 1024, nullptr, 0, nullptr}; run_gemm<0>(lds, proj + C_CKV, LDP, Wb + W_UKV, 128, NTOK, 1024, 128, E); }
#endif
#ifndef NO_S5P2
                s5h_pass2(P, li, lds, gw, NGW, wave, lane);
#endif
            } } else if constexpr (k == 4) { if (PHON(4)) {
#ifndef NO_ATTN
                attn_phase(P, li, lds, vcu, wave, lane);
#endif
                __syncthreads();
#ifndef NO_GLU
                { EpiB<3> E{yd, 512, 512, nullptr, 0, nullptr}; run_gemm<3>(lds, proj + C_DU, LDP, Wb + W_GLU, 512, NTOK, 1024, 512, E); }
#endif
            } } else if constexpr (k == 5) { if (PHON(5)) {
#pragma unroll 1
                for (int b = 0; b < 4; ++b) {
                    { EpiB<1> E{gatebuf, LDP, 1024, nullptr, 0, nullptr}; run_gemm<1>(lds, xn, 1024, Wb + W_GATE + (size_t)b * 1024 * 1024, 1024, NTOK, 1024, 1024, E); }
                    const bf16_t* ya = b == 0 ? proj + C_AQ : b == 1 ? proj + C_BQ : b == 2 ? mlaq : yd; const int lda = b < 2 ? LDP : b == 2 ? 768 : 512;
                    if (b == 0) { EpiB<4> E{mixed, 1024, 1024, gatebuf, LDP, nullptr}; run_gemm<4>(lds, ya, lda, Wb + W_BR + (size_t)b * 524288, 512, NTOK, 1024, 512, E); }
                    else { EpiB<5> E{mixed, 1024, 1024, gatebuf, LDP, nullptr}; run_gemm<5>(lds, ya, lda, Wb + W_BR + (size_t)b * 524288, 512, NTOK, 1024, 512, E); }
                }
            } } else if constexpr (k == 6) { if (PHON(6)) {
                EpiB<0> E{tmp1, 1024, 1024, nullptr, 0, nullptr}; run_gemm<0>(lds, mixed, 1024, Wb + W_OUT, 1024, NTOK, 1024, 1024, E);
            } } else if constexpr (k == 7) { if (PHON(7)) {
                resnorm_rows(li == 0 ? P->in[0] : P->out, tmp1, P->in[2] + li * 1024, P->out, P->in[3] + li * 1024, xn, gw, NGW, lane);
            } } else if constexpr (k == 8) { if (PHON(8)) {
                EpiB<2> E{hid, 4096, 4096, nullptr, 0, nullptr}; run_gemm<2>(lds, xn, 1024, Wb + W_F1, 1024, NTOK, 4096, 1024, E);
            } } else if constexpr (k == 9) { if (PHON(9)) {
                EpiB<0> E{tmp2, 1024, 1024, nullptr, 0, nullptr}; run_gemm<0>(lds, hid, 4096, Wb + W_F2, 4096, NTOK, 1024, 4096, E);
            } } else { if (PHON(10)) {
                const bool last = (li == DEPTH_ - 1);
                resnorm_rows(P->out, tmp2, P->in[4] + li * 1024, P->out, last ? nullptr : P->in[1] + (li + 1) * 1024, xn, gw, NGW, lane);
                if (!last) convert_weights(P, li + 1, lds, gw, NGW, wave, lane);
            } }
        }
}
__global__ void __launch_bounds__(512, 2) fwd_mega(Params Pv) {
    extern __shared__ __attribute__((aligned(16))) unsigned char lds_raw[];
    LAS unsigned char* lds = (LAS unsigned char*)lds_raw;
    const int G = gridDim.x, bx = blockIdx.x; const int vcu = (G % 8 == 0) ? (bx % 8) * (G / 8) + bx / 8 : bx; const int NGW = G * 8;
    const int ph_lo = Pv.ph_lo, ph_hi = Pv.ph_hi;
    volatile LAS unsigned* bst = (volatile LAS unsigned*)(lds + 147456);
    if (threadIdx.x < 2) bst[threadIdx.x] = 0u;
    __syncthreads();
    XcdBarrier xbar = xcd_barrier_post((unsigned*)(Pv.ws + OFF_CTL), bst);
#define PHASE(n) if (ph_lo <= (n) && (n) < ph_hi) { phase_body<n>(lds, vcu, NGW); if ((n) + 1 < ph_hi) { if (ph_hi > NPHASE) { __syncthreads(); cg::this_grid().sync(); } else xcd_barrier(xbar); } }
    PHASE(0) PHASE(1) PHASE(2) PHASE(3) PHASE(4) PHASE(5) PHASE(6) PHASE(7) PHASE(8) PHASE(9) PHASE(10)
    PHASE(11) PHASE(12) PHASE(13) PHASE(14) PHASE(15) PHASE(16) PHASE(17) PHASE(18) PHASE(19) PHASE(20)
#undef PHASE
}

extern "C" void kernel_launch(void* const* d_in, const int* in_sizes, int n_in, void* d_out, int out_size, void* d_ws, size_t ws_size, hipStream_t stream) {
    static int ready = 0;
    if (!ready) {
        if (n_in != 34 || out_size != NTOK * DMODEL || ws_size < WS_NEED) { fprintf(stderr, "kernel_launch: unexpected shapes (n_in %d out %d ws %zu)\n", n_in, out_size, ws_size); ready = -1; return; }
        if (hipFuncSetAttribute((const void*)fwd_mega, hipFuncAttributeMaxDynamicSharedMemorySize, LDS_BYTES) != hipSuccess) { fprintf(stderr, "kernel_launch: hipFuncSetAttribute failed\n"); ready = -1; return; }
        int per_cu = 0; (void)hipOccupancyMaxActiveBlocksPerMultiprocessor(&per_cu, (const void*)fwd_mega, 512, LDS_BYTES); (void)hipGetLastError();
        if (per_cu < 1) fprintf(stderr, "kernel_launch: occupancy query says %d blocks per CU\n", per_cu);
        ready = 1;
    }
    if (ready < 0) return;
    Params p{};
    for (int i = 0; i < 34; ++i) p.in[i] = (const float*)d_in[i];
    p.out = (float*)d_out; p.ws = (unsigned char*)d_ws;
#if MK_ONE_LAUNCH
    p.ph_lo = 0; p.ph_hi = NPHASE;
    if (hipMemsetAsync((char*)d_ws + OFF_CTL, 0, CTL_BYTES, stream) != hipSuccess) { fprintf(stderr, "kernel_launch: hipMemsetAsync failed\n"); return; }
    void* args[] = {&p};
    hipError_t e = hipLaunchCooperativeKernel((const void*)fwd_mega, dim3(256), dim3(512), args, LDS_BYTES, stream);
    if (e != hipSuccess) fprintf(stderr, "cooperative launch failed: %s\n", hipGetErrorString(e));
#else
    for (int ph = 0; ph < NPHASE; ++ph) { p.ph_lo = ph; p.ph_hi = ph + 1; hipLaunchKernelGGL(fwd_mega, dim3(256), dim3(512), LDS_BYTES, stream, p); }
#endif
}
```

```cpp
#include <hip/hip_runtime.h>
#include <hip/hip_cooperative_groups.h>
#include <cstdio>
#include <cstdint>
namespace cg = cooperative_groups;
#ifndef PHMASK
#define PHMASK 0x7ff
#endif
#define PHON(k) ((PHMASK >> (k)) & 1)
#ifndef MK_ONE_LAUNCH
#define MK_ONE_LAUNCH 1
#endif
namespace pg8 {
#define PG8_LAS __attribute__((address_space(3)))
typedef unsigned short bf16_t;
typedef short bf16x8 __attribute__((ext_vector_type(8)));
typedef float f32x4 __attribute__((ext_vector_type(4)));
typedef unsigned u32x4 __attribute__((ext_vector_type(4)));
constexpr int BM = 256, BK = 64, HALF = 128, HTB = HALF * BK * 2  , STAGE_BYTES = 8 * HTB, NXCD = 8, WGM = 8;

__host__ __device__ __forceinline__ int lds_byte(int r, int c) { const int st = (r >> 4) * 2 + (c >> 5), rr = r & 15, cc = c & 31, ob = rr * 64 + cc * 2; return st * 1024 + (ob ^ (((ob >> 9) & 1) << 5)); }
__host__ __device__ __forceinline__ void stage_rc(int b, int& R, int& C) { const int st = b / 1024, sb = b % 1024, swz = sb ^ (((sb >> 9) & 1) << 5); R = (st >> 1) * 16 + swz / 64; C = (st & 1) * 32 + (swz % 64) / 2; }
__host__ __device__ __forceinline__ int perm32(int rho) { const int n = rho >> 4, i = rho & 15; return 8 * (i >> 2) + 4 * n + (i & 3); }

struct Unit { int pm, pn; };
struct Gemm { const bf16_t* A; const bf16_t* Bt; int M, N, K, lda, ldb; };

struct StaticOrder {
    int nM, nN, nwg, G, c;
    __host__ __device__ void init(int M, int N, int G_, int c_) { nM = M / BM; nN = N / BM; nwg = nM * nN; G = G_; c = c_; }
    __host__ __device__ bool next(int i, Unit& u) const {
        const long L = (long)i * G + c; if (L >= nwg) return false;
        int wgid = (int)L; { const int q = nwg / NXCD, r = nwg % NXCD, xcd = wgid % NXCD, off = wgid / NXCD; wgid = (xcd < r ? xcd * (q + 1) : r * (q + 1) + (xcd - r) * q) + off; }
        const int nig = WGM * nN, gid = wgid / nig, fm = gid * WGM, gsz = (nM - fm) < WGM ? (nM - fm) : WGM;
        u.pm = fm + ((wgid % nig) % gsz); u.pn = (wgid % nig) / gsz; return true;
    }
    __device__ __forceinline__ void a_ready(const Unit&) const {}
    __device__ __forceinline__ void done(const Unit&) const {}
};

__device__ __forceinline__ unsigned cvt_pk_bf16(float lo, float hi) { unsigned r; asm volatile("v_cvt_pk_bf16_f32 %0, %1, %2" : "=v"(r) : "v"(lo), "v"(hi)); return r; }
template <class Epi, class Sched, bool ALIGN_EPI = false, bool SP2 = false>
__device__ __forceinline__ void gemm_phase(PG8_LAS unsigned char* lds, const Gemm g, const Sched& S, const Epi& E) {
    int tid_ = threadIdx.x; asm volatile("" : "+v"(tid_));
    const int tid = tid_, wid = __builtin_amdgcn_readfirstlane(tid >> 6), lane = tid & 63, wr = wid >> 2, wc = wid & 3, fr = lane & 15, fq = lane >> 4;
    const int K = g.K, nt = K / BK;
    unsigned voffA[2], voffB[2];
#pragma unroll
    for (int i = 0; i < 2; ++i) { int R, C; stage_rc(tid * 16 + i * 8192, R, C); const int Rb = Epi::PERM ? ((R & ~31) + perm32(R & 31)) : R;
        voffA[i] = (unsigned)(R * g.lda + C) * 2u; voffB[i] = (unsigned)(Rb * g.ldb + C) * 2u; }
    const size_t kstep = (size_t)(BK * 2);
    const size_t hstepA = (size_t)HALF * g.lda * 2, hstepB = (size_t)HALF * g.ldb * 2;
    const size_t tstepA = 2 * hstepA, tstepB = 2 * hstepB;
    const unsigned ldsw = (unsigned)wid * 1024u;
    const int aoff = lds_byte(wr * 64 + fr, fq * 8), boff = lds_byte(wc * 32 + fr, fq * 8);
#define PG8_SA(b, h) (((b) * 2 + (h)) * HTB)
#define PG8_SB(b, h) ((4 + (b) * 2 + (h)) * HTB)
#define PG8_STAGE(bufoff, gbase, voff) do { _Pragma("unroll") for (int _i = 0; _i < 2; ++_i) \
        __builtin_amdgcn_global_load_lds((const unsigned*)((const char*)(gbase) + (voff)[_i]), (PG8_LAS unsigned*)(lds + (bufoff) + ldsw + _i * 8192), 16, 0, 0); } while (0)
#define PG8_LDA(dst, b, h) do { _Pragma("unroll") for (int m = 0; m < 4; ++m) _Pragma("unroll") for (int k = 0; k < 2; ++k) dst[m][k] = *(const PG8_LAS bf16x8*)(lds + PG8_SA(b, h) + aoff + m * 2048 + k * 1024); } while (0)
#define PG8_LDB(dst, b, h) do { _Pragma("unroll") for (int n = 0; n < 2; ++n) _Pragma("unroll") for (int k = 0; k < 2; ++k) dst[n][k] = *(const PG8_LAS bf16x8*)(lds + PG8_SB(b, h) + boff + n * 2048 + k * 1024); } while (0)
#define PG8_MMA(ai, bj, At, Bt) do { __builtin_amdgcn_s_setprio(1); _Pragma("unroll") for (int m = 0; m < 4; ++m) _Pragma("unroll") for (int n = 0; n < 2; ++n) _Pragma("unroll") for (int k = 0; k < 2; ++k) \
        acc[ai][bj][m][n] = __builtin_amdgcn_mfma_f32_16x16x32_bf16(Bt[n][k], At[m][k], acc[ai][bj][m][n], 0, 0, 0); __builtin_amdgcn_s_setprio(0); } while (0)
#define PG8_WAIT_V(n) asm volatile("s_waitcnt vmcnt(" #n ")" ::: "memory")
#define PG8_WAIT_L(n) asm volatile("s_waitcnt lgkmcnt(" #n ")" ::: "memory")
#define PG8_BAR __builtin_amdgcn_s_barrier()
#define PG8_SCHED __builtin_amdgcn_sched_barrier(0)
    Unit cur, nxt; int ui = 0;
    if (!S.next(0, cur)) return;
    f32x4 acc[2][2][4][2];
#pragma unroll
    for (int a = 0; a < 2; ++a)
#pragma unroll
        for (int b = 0; b < 2; ++b)
#pragma unroll
            for (int m = 0; m < 4; ++m)
#pragma unroll
                for (int n = 0; n < 2; ++n) acc[a][b][m][n] = (f32x4){0.f, 0.f, 0.f, 0.f};
    bf16x8 At[4][2], B0[2][2], B1[2][2];
    const char* cA = (const char*)g.A + (size_t)cur.pm * tstepA; const char* cB = (const char*)g.Bt + (size_t)cur.pn * tstepB;
    S.a_ready(cur);
    if constexpr (SP2) {
        PG8_STAGE(PG8_SB(0, 0), cB, voffB); PG8_STAGE(PG8_SB(0, 1), cB + hstepB, voffB); PG8_STAGE(PG8_SA(0, 0), cA, voffA); PG8_STAGE(PG8_SA(0, 1), cA + hstepA, voffA);
        if (wr == 1) PG8_BAR;
        PG8_WAIT_V(2); PG8_BAR;
        PG8_STAGE(PG8_SB(1, 0), cB + kstep, voffB); PG8_STAGE(PG8_SA(1, 0), cA + kstep, voffA); PG8_STAGE(PG8_SB(1, 1), cB + hstepB + kstep, voffB);
        PG8_WAIT_V(6); PG8_BAR;
    } else {
        PG8_STAGE(PG8_SB(0, 0), cB, voffB); PG8_STAGE(PG8_SA(0, 0), cA, voffA); PG8_STAGE(PG8_SB(0, 1), cB + hstepB, voffB); PG8_STAGE(PG8_SA(0, 1), cA + hstepA, voffA);
        if (wr == 1) PG8_BAR;
        PG8_WAIT_V(4); PG8_BAR;
        PG8_STAGE(PG8_SB(1, 0), cB + kstep, voffB); PG8_STAGE(PG8_SA(1, 0), cA + kstep, voffA); PG8_STAGE(PG8_SB(1, 1), cB + hstepB + kstep, voffB);
        PG8_WAIT_V(6); PG8_BAR;
    }
    for (;;) {
        const bool has_next = S.next(ui + 1, nxt);
        const char* nA = has_next ? (const char*)g.A + (size_t)nxt.pm * tstepA : cA; const char* nB = has_next ? (const char*)g.Bt + (size_t)nxt.pn * tstepB : cB;
        for (int t = 0; t < nt; t += 2) {
            const bool last = (t == nt - 2);
            const char* a1 = cA + (size_t)(t + 1) * kstep;
            const char* a2 = last ? nA : cA + (size_t)(t + 2) * kstep; const char* b2 = last ? nB : cB + (size_t)(t + 2) * kstep;
            const char* a3 = a2 + kstep; const char* b3 = b2 + kstep;
            if (last && has_next) S.a_ready(nxt);
            if constexpr (SP2) {
            PG8_LDB(B0, 0, 0); PG8_LDB(B1, 0, 1); PG8_SCHED; PG8_LDA(At, 0, 0); PG8_STAGE(PG8_SA(1, 1), a1 + hstepA, voffA);
            PG8_WAIT_V(8); PG8_WAIT_L(0); PG8_BAR; PG8_MMA(0, 0, At, B0); PG8_MMA(0, 1, At, B1); PG8_BAR; PG8_SCHED;
            PG8_LDA(At, 0, 1); PG8_STAGE(PG8_SB(0, 0), b2, voffB); PG8_STAGE(PG8_SB(0, 1), b2 + hstepB, voffB); PG8_STAGE(PG8_SA(0, 0), a2, voffA);
            PG8_WAIT_V(8); PG8_WAIT_L(0); PG8_BAR; PG8_MMA(1, 0, At, B0); PG8_MMA(1, 1, At, B1); PG8_BAR; PG8_SCHED;
            PG8_LDB(B0, 1, 0); PG8_LDB(B1, 1, 1); PG8_SCHED; PG8_LDA(At, 1, 0); PG8_STAGE(PG8_SA(0, 1), a2 + hstepA, voffA);
            PG8_WAIT_V(8); PG8_WAIT_L(0); PG8_BAR; PG8_MMA(0, 0, At, B0); PG8_MMA(0, 1, At, B1); PG8_BAR; PG8_SCHED;
            PG8_LDA(At, 1, 1); PG8_STAGE(PG8_SB(1, 0), b3, voffB); PG8_STAGE(PG8_SB(1, 1), b3 + hstepB, voffB); PG8_STAGE(PG8_SA(1, 0), a3, voffA);
            PG8_WAIT_V(8); PG8_WAIT_L(0); PG8_BAR; PG8_MMA(1, 0, At, B0); PG8_MMA(1, 1, At, B1); PG8_BAR; PG8_SCHED;
            } else {
            PG8_LDB(B0, 0, 0); PG8_SCHED; PG8_LDA(At, 0, 0); PG8_STAGE(PG8_SA(1, 1), a1 + hstepA, voffA);
            PG8_WAIT_L(8); PG8_BAR; PG8_WAIT_L(0); PG8_MMA(0, 0, At, B0); PG8_BAR; PG8_SCHED;
            PG8_LDB(B1, 0, 1); PG8_STAGE(PG8_SB(0, 0), b2, voffB);
            PG8_BAR; PG8_WAIT_L(0); PG8_MMA(0, 1, At, B1); PG8_BAR;
            PG8_LDA(At, 0, 1); PG8_STAGE(PG8_SA(0, 0), a2, voffA);
            PG8_BAR; PG8_WAIT_L(0); PG8_MMA(1, 0, At, B0); PG8_BAR; PG8_SCHED;
            PG8_STAGE(PG8_SB(0, 1), b2 + hstepB, voffB);
            PG8_WAIT_V(6); PG8_BAR; PG8_MMA(1, 1, At, B1); PG8_BAR;
            PG8_LDB(B0, 1, 0); PG8_SCHED; PG8_LDA(At, 1, 0); PG8_STAGE(PG8_SA(0, 1), a2 + hstepA, voffA);
            PG8_WAIT_L(8); PG8_BAR; PG8_WAIT_L(0); PG8_MMA(0, 0, At, B0); PG8_BAR; PG8_SCHED;
            PG8_LDB(B1, 1, 1); PG8_STAGE(PG8_SB(1, 0), b3, voffB);
            PG8_BAR; PG8_WAIT_L(0); PG8_MMA(0, 1, At, B1); PG8_BAR;
            PG8_LDA(At, 1, 1); PG8_STAGE(PG8_SA(1, 0), a3, voffA);
            PG8_BAR; PG8_WAIT_L(0); PG8_MMA(1, 0, At, B0); PG8_BAR; PG8_SCHED;
            PG8_STAGE(PG8_SB(1, 1), b3 + hstepB, voffB);
            PG8_WAIT_V(6); PG8_BAR; PG8_MMA(1, 1, At, B1); PG8_BAR;
            }
        }
        if constexpr (ALIGN_EPI) { if (wr == 0) PG8_BAR; }
        if constexpr (!Epi::AFTER_DRAIN) { E(acc, cur, wr, wc, fr, fq); S.done(cur); }
        if (!has_next) break;
#pragma unroll
        for (int a = 0; a < 2; ++a)
#pragma unroll
            for (int b = 0; b < 2; ++b)
#pragma unroll
                for (int m = 0; m < 4; ++m)
#pragma unroll
                    for (int n = 0; n < 2; ++n) acc[a][b][m][n] = (f32x4){0.f, 0.f, 0.f, 0.f};
        cur = nxt; cA = nA; cB = nB; ++ui;
        if constexpr (ALIGN_EPI) { if (wr == 1) PG8_BAR; }
    }
    PG8_WAIT_V(0);
    if constexpr (!ALIGN_EPI) { if (wr == 0) PG8_BAR; }
    PG8_BAR;
    if constexpr (Epi::AFTER_DRAIN) { E.fused(acc, cur, wr, wc, fr, fq, lds, wid, lane); S.done(cur); }
#undef PG8_SA
#undef PG8_SB
#undef PG8_STAGE
#undef PG8_LDA
#undef PG8_LDB
#undef PG8_MMA
#undef PG8_WAIT_V
#undef PG8_WAIT_L
#undef PG8_BAR
#undef PG8_SCHED
}
}

#define LAS __attribute__((address_space(3)))
typedef unsigned short bf16_t;
typedef short bf16x8 __attribute__((ext_vector_type(8)));
typedef float f32x4 __attribute__((ext_vector_type(4)));
typedef float f32x16 __attribute__((ext_vector_type(16)));
typedef unsigned u32x4 __attribute__((ext_vector_type(4)));
typedef unsigned u32x2 __attribute__((ext_vector_type(2)));
typedef float f32x2 __attribute__((ext_vector_type(2)));

constexpr int NTOK = 16384, DMODEL = 1024, SEQL = 4096, NBATCH = 4, DEPTH_ = 2, FFH = 4096;
constexpr int LDP = 3232;
constexpr int C_AQ = 0, C_AK = 512, C_AV = 1024, C_BQ = 1536, C_BK = 2048, C_BV = 2176, C_CQ = 2304, C_CKV = 2560, C_CKR = 2688, C_DU = 2720;
constexpr int NPAD_IN = 3328;
constexpr float EPSN = 1e-6f;
constexpr float LOG2E = 1.4426950408889634f;
constexpr size_t MiB = 1u << 20;
constexpr size_t OFF_PROJ = 0, OFF_MLAQ = 101 * MiB, OFF_MLAKV = 125 * MiB, OFF_XN = 157 * MiB, OFF_YD = 189 * MiB, OFF_W = 205 * MiB, OFF_CARRY = 244 * MiB, OFF_ROPE = 248 * MiB, WS_NEED = 252 * MiB;
constexpr size_t W_IN = 0, W_GATE = 3407872, W_UQ = 7602176, W_UKV = 7798784, W_GLU = 7929856, W_BR = 8454144, W_OUT = 10551296, W_F1 = 11599872, W_F2 = 15794176;
constexpr int LDS_BYTES = 148480;
constexpr size_t OFF_CTL = 251 * MiB, CTL_BYTES = 16384;
constexpr int NPHASE = 1 + 10 * DEPTH_;
constexpr int S5_CH = 128, S5_NCH = SEQL / S5_CH;

struct Params { const float* in[34]; float* out; unsigned char* ws; int ph_lo, ph_hi; };
typedef const __attribute__((address_space(4))) Params* PPtr;

__device__ __forceinline__ float wave_sum(float v) {
#pragma unroll
    for (int o = 1; o < 64; o <<= 1) v += __shfl_xor(v, o);
    return v;
}
__device__ __forceinline__ unsigned cvtpk(float lo, float hi) { typedef __bf16 bf2 __attribute__((ext_vector_type(2))); f32x2 v = {lo, hi}; bf2 b = __builtin_convertvector(v, bf2); return __builtin_bit_cast(unsigned, b); }
__device__ __forceinline__ float bflo(unsigned w) { return __builtin_bit_cast(float, w << 16); }
__device__ __forceinline__ float bfhi(unsigned w) { return __builtin_bit_cast(float, w & 0xffff0000u); }
__device__ __forceinline__ float bf1(bf16_t h) { return __builtin_bit_cast(float, (unsigned)h << 16); }
__device__ __forceinline__ bf16_t tobf(float f) { return (bf16_t)(cvtpk(f, 0.f) & 0xffffu); }
__device__ __forceinline__ float fsigmoid(float x) { return __builtin_amdgcn_rcpf(1.f + __builtin_amdgcn_exp2f(-x * LOG2E)); }
__device__ __forceinline__ void sincos_d(double a, float& s, float& c) {
    const double k = __builtin_rint(a * 0.15915494309189535); const double r = a - k * 6.283185307179586476925;
    const double x = r * 0.25, x2 = x * x;
    const double sn = x * (1.0 + x2 * (-1.0 / 6 + x2 * (1.0 / 120 + x2 * (-1.0 / 5040 + x2 * (1.0 / 362880 + x2 * (-1.0 / 39916800 + x2 * (1.0 / 6227020800.0)))))));
    const double cs = 1.0 + x2 * (-0.5 + x2 * (1.0 / 24 + x2 * (-1.0 / 720 + x2 * (1.0 / 40320 + x2 * (-1.0 / 3628800 + x2 * (1.0 / 479001600.0 + x2 * (-1.0 / 87178291200.0)))))));
    const double s2 = 2 * sn * cs, c2 = 1 - 2 * sn * sn; s = (float)(2 * s2 * c2); c = (float)(1 - 2 * s2 * s2);
}

__device__ __forceinline__ void st16_wt(void* p, u32x4 v) { asm volatile("global_store_dwordx4 %0, %1, off sc1\n\ts_nop 4" :: "v"(p), "v"(v) : "memory"); }
template <int MODE> struct EpiB {
    static constexpr bool PERM = true, AFTER_DRAIN = false;
    bf16_t* O; int ldc; int ncols; const bf16_t* G; int ldg; const float* rope;
    __device__ __forceinline__ void operator()(const f32x4 (&acc)[2][2][4][2], const pg8::Unit& u, int wr, int wc, int fr, int fq) const {
        const int row0 = u.pm * 256 + wr * 64 + fr;
        if constexpr (MODE == 3) {
            const int col = u.pn * 128 + wc * 32 + 8 * fq;
#pragma unroll
            for (int ai = 0; ai < 2; ++ai)
#pragma unroll
                for (int m = 0; m < 4; ++m) {
                    const int row = row0 + ai * 128 + m * 16;
                    f32x4 v0 = acc[ai][0][m][0], v1 = acc[ai][0][m][1]; const f32x4 g0 = acc[ai][1][m][0], g1 = acc[ai][1][m][1];
#pragma unroll
                    for (int i = 0; i < 4; ++i) { v0[i] *= fsigmoid(g0[i]); v1[i] *= fsigmoid(g1[i]); }
                    u32x4 w; w.x = cvtpk(v0[0], v0[1]); w.y = cvtpk(v0[2], v0[3]); w.z = cvtpk(v1[0], v1[1]); w.w = cvtpk(v1[2], v1[3]);
                    st16_wt(O + (size_t)row * ldc + col, w);
                }
        } else {
#pragma unroll
            for (int ai = 0; ai < 2; ++ai)
#pragma unroll
                for (int m = 0; m < 4; ++m) {
                    const int row = row0 + ai * 128 + m * 16;
#pragma unroll
                    for (int bj = 0; bj < 2; ++bj) {
                        const int col = u.pn * 256 + bj * 128 + wc * 32 + 8 * fq;
                        if (col >= ncols) continue;
                        f32x4 v0 = acc[ai][bj][m][0], v1 = acc[ai][bj][m][1];
                        if constexpr (MODE == 1) {
#pragma unroll
                            for (int i = 0; i < 4; ++i) { v0[i] = fsigmoid(v0[i]); v1[i] = fsigmoid(v1[i]); }
                        }
                        if constexpr (MODE == 2) {
#pragma unroll
                            for (int i = 0; i < 4; ++i) { const float a = fmaxf(v0[i], 0.f), b = fmaxf(v1[i], 0.f); v0[i] = a * a; v1[i] = b * b; }
                        }
                        if constexpr (MODE == 4 || MODE == 5) {
                            const u32x4 gw = *(const u32x4*)(G + (size_t)row * ldg + col);
                            v0[0] *= bflo(gw.x); v0[1] *= bfhi(gw.x); v0[2] *= bflo(gw.y); v0[3] *= bfhi(gw.y);
                            v1[0] *= bflo(gw.z); v1[1] *= bfhi(gw.z); v1[2] *= bflo(gw.w); v1[3] *= bfhi(gw.w);
                            if constexpr (MODE == 5) {
                                const u32x4 ow = *(const u32x4*)(O + (size_t)row * ldc + col);
                                v0[0] += bflo(ow.x); v0[1] += bfhi(ow.x); v0[2] += bflo(ow.y); v0[3] += bfhi(ow.y);
                                v1[0] += bflo(ow.z); v1[1] += bfhi(ow.z); v1[2] += bflo(ow.w); v1[3] += bfhi(ow.w);
                            }
                        }
                        if constexpr (MODE == 6) {
                            if (col >= 512) {
                                const int pos = row & (SEQL - 1);
                                const f32x4 cs0 = *(const f32x4*)(rope + ((size_t)pos * 16 + 4 * fq) * 2), cs1 = *(const f32x4*)(rope + ((size_t)pos * 16 + 4 * fq + 2) * 2);
                                float a, b;
                                a = v0[0]; b = v0[1]; v0[0] = a * cs0[0] - b * cs0[1]; v0[1] = a * cs0[1] + b * cs0[0];
                                a = v0[2]; b = v0[3]; v0[2] = a * cs0[2] - b * cs0[3]; v0[3] = a * cs0[3] + b * cs0[2];
                                a = v1[0]; b = v1[1]; v1[0] = a * cs1[0] - b * cs1[1]; v1[1] = a * cs1[1] + b * cs1[0];
                                a = v1[2]; b = v1[3]; v1[2] = a * cs1[2] - b * cs1[3]; v1[3] = a * cs1[3] + b * cs1[2];
                            }
                        }
                        u32x4 w; w.x = cvtpk(v0[0], v0[1]); w.y = cvtpk(v0[2], v0[3]); w.z = cvtpk(v1[0], v1[1]); w.w = cvtpk(v1[2], v1[3]);
                        if constexpr (MODE == 0 || MODE == 2) st16_wt(O + (size_t)row * ldc + col, w); else *(u32x4*)(O + (size_t)row * ldc + col) = w;
                        if constexpr (MODE == 4 || MODE == 5) asm volatile("" ::: "memory");
                    }
                }
        }
    }
};

template <int MODE>
__device__ __forceinline__ void run_gemm(LAS unsigned char* lds, const bf16_t* A, int lda, const bf16_t* Bt, int ldb, int M, int N, int K, const EpiB<MODE>& E) {
    asm volatile("" : "+s"(K), "+s"(lda), "+s"(ldb), "+s"(N));
    pg8::Gemm g{A, Bt, M, N, K, lda, ldb}; pg8::StaticOrder S; S.init(M, N, (int)gridDim.x, (int)blockIdx.x);
    pg8::gemm_phase<EpiB<MODE>, pg8::StaticOrder, true, true>(lds, g, S, E);
}

__device__ __forceinline__ int wrow_map(int mode, int n) {
    if (mode == 1) { const int hd = n / 96, w = n % 96; return w < 64 ? hd * 64 + w : 512 + hd * 32 + 2 * ((w - 64) & 15) + ((w - 64) >> 4); }
    if (mode == 2) { const int c = n & 511, t = c >> 7; return 256 * t + (n >> 9) * 128 + (c & 127); }
    return n;
}
__device__ __forceinline__ void transpose_item(const float* W, int K, int N, bf16_t* WT, int mode, LAS float* scr, int item, int lane) {
    const int nblk = N / 32, kb = item / nblk, nb = item % nblk, k0 = 64 * kb, n0 = 32 * nb;
#pragma unroll
    for (int i = 0; i < 32; ++i) { const int kk = 2 * i + (lane >> 5); scr[kk * 33 + (lane & 31)] = W[(size_t)(k0 + kk) * N + n0 + (lane & 31)]; }
    asm volatile("s_waitcnt lgkmcnt(0)" ::: "memory");
    const int c = lane & 7;
#pragma unroll
    for (int j = 0; j < 4; ++j) { const int n = (lane >> 3) + 8 * j; const LAS float* s = scr + (8 * c) * 33 + n;
        u32x4 o; o.x = cvtpk(s[0 * 33], s[1 * 33]); o.y = cvtpk(s[2 * 33], s[3 * 33]); o.z = cvtpk(s[4 * 33], s[5 * 33]); o.w = cvtpk(s[6 * 33], s[7 * 33]);
        *(u32x4*)(WT + (size_t)wrow_map(mode, n0 + n) * K + k0 + 8 * c) = o; }
    asm volatile("s_waitcnt lgkmcnt(0)" ::: "memory");
}
__device__ __forceinline__ void convert_weights(PPtr P, int li, LAS unsigned char* lds, int gw, int NGW, int wave, int lane) {
    LAS float* scr = (LAS float*)(lds + wave * 16384);
    bf16_t* Wb = (bf16_t*)(P->ws + OFF_W);
    constexpr int I_IN = 16 * 101, I_GATE = 16 * 128, I_UQ = 4 * 24, I_UKV = 2 * 32, I_GLU = 8 * 32, I_BR = 8 * 32, I_OUT = 16 * 32, I_F1 = 16 * 128, I_F2 = 64 * 32;
    constexpr int NIT = I_IN + I_GATE + I_UQ + I_UKV + I_GLU + 4 * I_BR + I_OUT + I_F1 + I_F2;
    for (int it = gw; it < NIT; it += NGW) {
        int r = it;
        if (r < I_IN) { transpose_item(P->in[5] + (size_t)li * 1024 * 3232, 1024, 3232, Wb + W_IN, 0, scr, r, lane); continue; } r -= I_IN;
        if (r < I_GATE) { transpose_item(P->in[6] + (size_t)li * 1024 * 4096, 1024, 4096, Wb + W_GATE, 0, scr, r, lane); continue; } r -= I_GATE;
        if (r < I_UQ) { transpose_item(P->in[16] + (size_t)li * 256 * 768, 256, 768, Wb + W_UQ, 1, scr, r, lane); continue; } r -= I_UQ;
        if (r < I_UKV) { transpose_item(P->in[17] + (size_t)li * 128 * 1024, 128, 1024, Wb + W_UKV, 0, scr, r, lane); continue; } r -= I_UKV;
        if (r < I_GLU) { transpose_item(P->in[26] + (size_t)li * 512 * 1024, 512, 1024, Wb + W_GLU, 2, scr, r, lane); continue; } r -= I_GLU;
        if (r < 4 * I_BR) { const int b = r / I_BR; transpose_item(P->in[27 + b] + (size_t)li * 512 * 1024, 512, 1024, Wb + W_BR + (size_t)b * 524288, 0, scr, r % I_BR, lane); continue; } r -= 4 * I_BR;
        if (r < I_OUT) { transpose_item(P->in[31] + (size_t)li * 1024 * 1024, 1024, 1024, Wb + W_OUT, 0, scr, r, lane); continue; } r -= I_OUT;
        if (r < I_F1) { transpose_item(P->in[32] + (size_t)li * 1024 * 4096, 1024, 4096, Wb + W_F1, 0, scr, r, lane); continue; } r -= I_F1;
        transpose_item(P->in[33] + (size_t)li * 4096 * 1024, 4096, 1024, Wb + W_F2, 0, scr, r, lane);
    }
    for (int i = gw * 64 + lane; i < 12288; i += NGW * 64) *(u32x4*)(Wb + W_IN + (size_t)3232 * 1024 + (size_t)i * 8) = (u32x4){0u, 0u, 0u, 0u};
}

__device__ __forceinline__ void prenorm_rows(const float* x, const float* g, bf16_t* xn, int gw, int NGW, int lane) {
    for (int row = gw; row < NTOK; row += NGW) {
        const f32x4* xr = (const f32x4*)(x + (size_t)row * DMODEL) + lane; f32x4 v[4]; float ss = 0.f;
#pragma unroll
        for (int j = 0; j < 4; ++j) { v[j] = xr[64 * j]; ss += (v[j][0] * v[j][0] + v[j][1] * v[j][1]) + (v[j][2] * v[j][2] + v[j][3] * v[j][3]); }
        const float rs = __builtin_amdgcn_rsqf(wave_sum(ss) * (1.f / DMODEL) + EPSN);
        u32x2* o = (u32x2*)(xn + (size_t)row * DMODEL) + lane;
#pragma unroll
        for (int j = 0; j < 4; ++j) { const f32x4 gg = ((const f32x4*)g)[lane + 64 * j]; u32x2 w; w.x = cvtpk(v[j][0] * rs * gg[0], v[j][1] * rs * gg[1]); w.y = cvtpk(v[j][2] * rs * gg[2], v[j][3] * rs * gg[3]); o[64 * j] = w; }
    }
}
__device__ __forceinline__ void resnorm_rows(const float* hin, const bf16_t* tmp, const float* g1, float* hout, const float* g2, bf16_t* xn, int gw, int NGW, int lane) {
    for (int row = gw; row < NTOK; row += NGW) {
        const u32x2* tr = (const u32x2*)(tmp + (size_t)row * DMODEL) + lane; f32x4 t[4]; float ss = 0.f;
#pragma unroll
        for (int j = 0; j < 4; ++j) { const u32x2 w = tr[64 * j]; t[j] = (f32x4){bflo(w.x), bfhi(w.x), bflo(w.y), bfhi(w.y)}; ss += (t[j][0] * t[j][0] + t[j][1] * t[j][1]) + (t[j][2] * t[j][2] + t[j][3] * t[j][3]); }
        const float rs = __builtin_amdgcn_rsqf(wave_sum(ss) * (1.f / DMODEL) + EPSN);
        const f32x4* hr = (const f32x4*)(hin + (size_t)row * DMODEL) + lane; f32x4* ho = (f32x4*)(hout + (size_t)row * DMODEL) + lane; float s2 = 0.f;
#pragma unroll
        for (int j = 0; j < 4; ++j) { const f32x4 gg = ((const f32x4*)g1)[lane + 64 * j]; f32x4 h = hr[64 * j];
            h[0] += t[j][0] * rs * gg[0]; h[1] += t[j][1] * rs * gg[1]; h[2] += t[j][2] * rs * gg[2]; h[3] += t[j][3] * rs * gg[3];
            st16_wt(ho + 64 * j, __builtin_bit_cast(u32x4, h)); t[j] = h; s2 += (h[0] * h[0] + h[1] * h[1]) + (h[2] * h[2] + h[3] * h[3]); }
        if (g2) {
            const float r2 = __builtin_amdgcn_rsqf(wave_sum(s2) * (1.f / DMODEL) + EPSN);
            u32x2* o = (u32x2*)(xn + (size_t)row * DMODEL) + lane;
#pragma unroll
            for (int j = 0; j < 4; ++j) { const f32x4 gg = ((const f32x4*)g2)[lane + 64 * j]; u32x2 w; w.x = cvtpk(t[j][0] * r2 * gg[0], t[j][1] * r2 * gg[1]); w.y = cvtpk(t[j][2] * r2 * gg[2], t[j][3] * r2 * gg[3]); o[64 * j] = w; }
        }
    }
}
__device__ __forceinline__ void prep_rows(bf16_t* proj, const float* gq, const float* gk, const float* mq, const float* mkv, const float* rope, int gw, int NGW, int lane) {
    const int j = lane & 15; const bool up = (lane & 16) != 0;
    for (int row = gw; row < NTOK; row += NGW) {
        bf16_t* pr = proj + (size_t)row * LDP; const int l = row & (SEQL - 1); const int pos = (lane < 32) ? (l >> 6) : (l & 63);
        const f32x2 cs = *(const f32x2*)(rope + ((size_t)pos * 16 + j) * 2);
        float hv[10];
#pragma unroll
        for (int hh = 0; hh < 10; ++hh) hv[hh] = bf1(pr[(hh < 8 ? C_BQ + hh * 64 : C_BK + (hh - 8) * 64) + lane]);
        const float ggq = gq[lane], ggk = gk[lane];
#pragma unroll
        for (int hh = 0; hh < 10; ++hh) {
            const int base = hh < 8 ? C_BQ + hh * 64 : C_BK + (hh - 8) * 64; const float gg = hh < 8 ? ggq : ggk;
            float v = hv[hh]; const float ss = wave_sum(v * v);
            v = v * __builtin_amdgcn_rsqf(ss * (1.f / 64) + EPSN) * gg;
            const float pv = __shfl_xor(v, 16);
            const float o = up ? (pv * cs[1] + v * cs[0]) : (v * cs[0] - pv * cs[1]);
            pr[base + lane] = tobf(o);
        }
        {
            const u32x2 w = *(const u32x2*)(pr + C_CQ + 4 * lane); f32x4 v = {bflo(w.x), bfhi(w.x), bflo(w.y), bfhi(w.y)};
            const float rs = __builtin_amdgcn_rsqf(wave_sum((v[0] * v[0] + v[1] * v[1]) + (v[2] * v[2] + v[3] * v[3])) * (1.f / 256) + EPSN); const f32x4 gg = ((const f32x4*)mq)[lane];
            u32x2 o; o.x = cvtpk(v[0] * rs * gg[0], v[1] * rs * gg[1]); o.y = cvtpk(v[2] * rs * gg[2], v[3] * rs * gg[3]); *(u32x2*)(pr + C_CQ + 4 * lane) = o;
        }
        {
            const unsigned w = *(const unsigned*)(pr + C_CKV + 2 * lane); const float a = bflo(w), b = bfhi(w);
            const float rs = __builtin_amdgcn_rsqf(wave_sum(a * a + b * b) * (1.f / 128) + EPSN); const f32x2 gg = ((const f32x2*)mkv)[lane];
            *(unsigned*)(pr + C_CKV + 2 * lane) = cvtpk(a * rs * gg[0], b * rs * gg[1]);
        }
        {
            const float v = bf1(pr[C_CKR + (lane & 31)]); const float pv = __shfl_xor(v, 16);
            const f32x2 c2 = *(const f32x2*)(rope + ((size_t)l * 16 + j) * 2);
            const float o = up ? (pv * c2[1] + v * c2[0]) : (v * c2[0] - pv * c2[1]);
            if (lane < 32) pr[C_CKR + 2 * j + (lane >> 4)] = tobf(o);
        }
    }
}

struct S5Lane { float lbr, lbi; f32x2 bb[16]; };
__device__ __forceinline__ void s5_setup(PPtr P, int li, int dir, int g, int p, S5Lane& L) {
    const size_t ga = ((size_t)(li * 2 + dir) * 32 + g);
    const float are = fminf(P->in[18][ga * 64 + p], -1e-4f), aim = P->in[19][ga * 64 + p]; const float dt = expf(P->in[20][ga]);
    const float mag = expf(are * dt); float sn, cn; sincos_d((double)(aim * dt), sn, cn);
    L.lbr = mag * cn; L.lbi = mag * sn;
    const float den = are * are + aim * aim, nre = L.lbr - 1.f;
    const float fre = (nre * are + L.lbi * aim) / den, fim = (L.lbi * are - nre * aim) / den;
    const f32x4* br = (const f32x4*)(P->in[21] + (ga * 64 + p) * 16); const f32x4* bi = (const f32x4*)(P->in[22] + (ga * 64 + p) * 16);
#pragma unroll
    for (int q = 0; q < 4; ++q) { const f32x4 r = br[q], i = bi[q];
#pragma unroll
        for (int e = 0; e < 4; ++e) L.bb[4 * q + e] = (f32x2){fre * r[e] - fim * i[e], fre * i[e] + fim * r[e]}; }
}
__device__ __forceinline__ void s5_step(const S5Lane& L, const LAS unsigned char* urow, float& sr, float& si) {
    const u32x4 ua = *(const LAS u32x4*)urow, ub = *(const LAS u32x4*)(urow + 16);
    f32x2 x2;
#define S5_U2(v) ((f32x2){(v), (v)})
    x2 = S5_U2(bflo(ua.x)) * L.bb[0];
    x2 = __builtin_elementwise_fma(S5_U2(bfhi(ua.x)), L.bb[1], x2);
    x2 = __builtin_elementwise_fma(S5_U2(bflo(ua.y)), L.bb[2], x2);
    x2 = __builtin_elementwise_fma(S5_U2(bfhi(ua.y)), L.bb[3], x2);
    x2 = __builtin_elementwise_fma(S5_U2(bflo(ua.z)), L.bb[4], x2);
    x2 = __builtin_elementwise_fma(S5_U2(bfhi(ua.z)), L.bb[5], x2);
    x2 = __builtin_elementwise_fma(S5_U2(bflo(ua.w)), L.bb[6], x2);
    x2 = __builtin_elementwise_fma(S5_U2(bfhi(ua.w)), L.bb[7], x2);
    x2 = __builtin_elementwise_fma(S5_U2(bflo(ub.x)), L.bb[8], x2);
    x2 = __builtin_elementwise_fma(S5_U2(bfhi(ub.x)), L.bb[9], x2);
    x2 = __builtin_elementwise_fma(S5_U2(bflo(ub.y)), L.bb[10], x2);
    x2 = __builtin_elementwise_fma(S5_U2(bfhi(ub.y)), L.bb[11], x2);
    x2 = __builtin_elementwise_fma(S5_U2(bflo(ub.z)), L.bb[12], x2);
    x2 = __builtin_elementwise_fma(S5_U2(bfhi(ub.z)), L.bb[13], x2);
    x2 = __builtin_elementwise_fma(S5_U2(bflo(ub.w)), L.bb[14], x2);
    x2 = __builtin_elementwise_fma(S5_U2(bfhi(ub.w)), L.bb[15], x2);
#undef S5_U2
    const float xr = x2[0], xi = x2[1];
    const float nr = L.lbr * sr - L.lbi * si + xr, ni = L.lbr * si + L.lbi * sr + xi; sr = nr; si = ni;
}
__device__ __forceinline__ void s5_stage_u(const bf16_t* proj, int b, int g, int ch, LAS unsigned char* ulds, int lane) {
    const bf16_t* src = proj + ((size_t)b * SEQL + (size_t)ch * S5_CH) * LDP + C_DU + g * 16;
#pragma unroll
    for (int it = 0; it < 4; ++it) { const int r = it * 32 + (lane >> 1), hf = lane & 1; *(LAS u32x4*)(ulds + r * 32 + hf * 16) = *(const u32x4*)(src + (size_t)r * LDP + hf * 8); }
    asm volatile("s_waitcnt vmcnt(0) lgkmcnt(0)" ::: "memory");
}
__device__ __forceinline__ void s5_pass1(PPtr P, int li, LAS unsigned char* lds, int gw, int NGW, int wave, int lane) {
    LAS unsigned char* ulds = lds + wave * 16640; const bf16_t* proj = (const bf16_t*)(P->ws + OFF_PROJ); f32x2* carry = (f32x2*)(P->ws + OFF_CARRY);
    for (int item = gw; item < NBATCH * 32 * S5_NCH; item += NGW) {
        const int ch = item % S5_NCH, g = (item / S5_NCH) % 32, b = item / (S5_NCH * 32);
        s5_stage_u(proj, b, g, ch, ulds, lane);
#pragma unroll 1
        for (int dir = 0; dir < 2; ++dir) {
            S5Lane L; s5_setup(P, li, dir, g, lane, L); float sr = 0.f, si = 0.f;
#pragma unroll 2
            for (int jj = 0; jj < S5_CH; ++jj) { const int j = dir ? S5_CH - 1 - jj : jj; s5_step(L, ulds + j * 32, sr, si); }
            carry[((((size_t)b * 32 + g) * S5_NCH + ch) * 2 + dir) * 64 + lane] = (f32x2){sr, si};
        }
        asm volatile("s_waitcnt lgkmcnt(0)" ::: "memory");
    }
}
__device__ __forceinline__ void s5_pass2(PPtr P, int li, LAS unsigned char* lds, int gw, int NGW, int wave, int lane) {
    LAS unsigned char* ulds = lds + wave * 16640; LAS unsigned char* slds = ulds + 4096; LAS float* ylds = (LAS float*)(ulds + 4096 + 4352);
    bf16_t* proj = (bf16_t*)(P->ws + OFF_PROJ); const f32x2* carry = (const f32x2*)(P->ws + OFF_CARRY);
    const int hq = lane & 15, kq = lane >> 4;
    for (int item = gw; item < NBATCH * 32 * S5_NCH; item += NGW) {
        const int ch = item % S5_NCH, g = (item / S5_NCH) % 32, b = item / (S5_NCH * 32);
        s5_stage_u(proj, b, g, ch, ulds, lane);
#pragma unroll 1
        for (int dir = 0; dir < 2; ++dir) {
            S5Lane L; s5_setup(P, li, dir, g, lane, L);
            float cr = L.lbr, ci = L.lbi;
#pragma unroll
            for (int q = 0; q < 7; ++q) { const float nr = cr * cr - ci * ci, ni = 2.f * cr * ci; cr = nr; ci = ni; }
            float sr = 0.f, si = 0.f;
            const f32x2* cb = carry + ((((size_t)b * 32 + g) * S5_NCH) * 2 + dir) * 64 + lane;
            if (dir == 0) {
#pragma unroll 4
                for (int c = 0; c < ch; ++c) { const f32x2 e = cb[(size_t)c * 128]; const float nr = cr * sr - ci * si + e[0], ni = cr * si + ci * sr + e[1]; sr = nr; si = ni; } }
            else {
#pragma unroll 4
                for (int c = S5_NCH - 1; c > ch; --c) { const f32x2 e = cb[(size_t)c * 128]; const float nr = cr * sr - ci * si + e[0], ni = cr * si + ci * sr + e[1]; sr = nr; si = ni; } }
            bf16x8 bc[4];
            { const size_t cbase = (((size_t)(li * 2 + dir) * 32 + g) * 16 + hq) * 64;
#pragma unroll
              for (int ks = 0; ks < 4; ++ks) { const f32x4 re = *(const f32x4*)(P->in[23] + cbase + 16 * ks + 4 * kq), im = *(const f32x4*)(P->in[24] + cbase + 16 * ks + 4 * kq);
                  u32x4 w; w.x = cvtpk(re[0], -im[0]); w.y = cvtpk(re[1], -im[1]); w.z = cvtpk(re[2], -im[2]); w.w = cvtpk(re[3], -im[3]); bc[ks] = __builtin_bit_cast(bf16x8, w); } }
#pragma unroll 1
            for (int sb = 0; sb < S5_CH / 16; ++sb) {
                const int sub = dir ? S5_CH / 16 - 1 - sb : sb;
#pragma unroll 2
                for (int q = 0; q < 16; ++q) { const int jj = dir ? 15 - q : q; s5_step(L, ulds + (sub * 16 + jj) * 32, sr, si); *(LAS unsigned*)(slds + jj * 272 + lane * 4) = cvtpk(sr, si); }
                asm volatile("s_waitcnt lgkmcnt(0)" ::: "memory");
                f32x4 acc = {0.f, 0.f, 0.f, 0.f};
#pragma unroll
                for (int ks = 0; ks < 4; ++ks) { const bf16x8 a = *(const LAS bf16x8*)(slds + hq * 272 + ks * 64 + kq * 16); acc = __builtin_amdgcn_mfma_f32_16x16x32_bf16(a, bc[ks], acc, 0, 0, 0); }
                asm volatile("s_nop 15\n\ts_nop 15" : "+v"(acc));
                LAS float* yp = ylds + (sub * 16 + kq * 4) * 16 + hq;
                if (dir == 0) { yp[0] = acc[0]; yp[16] = acc[1]; yp[32] = acc[2]; yp[48] = acc[3]; }
                else { yp[0] += acc[0]; yp[16] += acc[1]; yp[32] += acc[2]; yp[48] += acc[3]; }
                asm volatile("s_waitcnt lgkmcnt(0)" ::: "memory");
            }
        }
        const float dd = P->in[25][((size_t)li * 32 + g) * 16 + hq];
        bf16_t* dst = proj + ((size_t)b * SEQL + (size_t)ch * S5_CH) * LDP + C_DU + g * 16 + hq;
#pragma unroll 4
        for (int it = 0; it < S5_CH / 4; ++it) { const int r = it * 4 + kq; const float uu = bf1(*(const LAS bf16_t*)(ulds + r * 32 + hq * 2)); const float y = ylds[r * 16 + hq] + dd * uu;
            const float z = 1.5957691216057308f * (y + 0.044715f * y * y * y); dst[(size_t)r * LDP] = tobf(y * fsigmoid(z)); }
        asm volatile("s_waitcnt lgkmcnt(0)" ::: "memory");
    }
}

constexpr int S5_XP = 132;
constexpr int S5_WLDS = 4096 + 16 * S5_XP * 4 + 16 * 272;
template <int DIR, bool PASS2>
__device__ __forceinline__ void s5_sub(LAS unsigned char* ulds, const bf16x8 (&bb)[8], const bf16x8 (&bc)[4], float lbr, float lbi, float& sr, float& si, f32x4& yacc, int sub, int lane) {
    LAS float* xlds = (LAS float*)(ulds + 4096); LAS unsigned char* slds = ulds + 4096 + 16 * S5_XP * 4;
    const int hq = lane & 15, kq = lane >> 4;
    u32x4 uw = {0u, 0u, 0u, 0u};
    if (kq < 2) uw = *(const LAS u32x4*)(ulds + (sub * 16 + hq) * 32 + kq * 16);
    const bf16x8 ua = __builtin_bit_cast(bf16x8, uw);
    LAS float* xp = xlds + (4 * kq) * S5_XP + hq;
    f32x4 xs[8];
#pragma unroll
    for (int nt = 0; nt < 8; ++nt) xs[nt] = __builtin_amdgcn_mfma_f32_16x16x32_bf16(ua, bb[nt], (f32x4){0.f, 0.f, 0.f, 0.f}, 0, 0, 0);
    asm volatile("s_nop 15\n\ts_nop 15" : "+v"(xs[0]), "+v"(xs[1]), "+v"(xs[2]), "+v"(xs[3]), "+v"(xs[4]), "+v"(xs[5]), "+v"(xs[6]), "+v"(xs[7]));
#pragma unroll
    for (int nt = 0; nt < 8; ++nt) { xp[16 * nt] = xs[nt][0]; xp[16 * nt + S5_XP] = xs[nt][1]; xp[16 * nt + 2 * S5_XP] = xs[nt][2]; xp[16 * nt + 3 * S5_XP] = xs[nt][3]; }
    asm volatile("s_waitcnt lgkmcnt(0)" ::: "memory");
    const LAS float* xr = xlds + 2 * lane; LAS unsigned char* sw = slds + lane * 4;
#pragma unroll
    for (int q = 0; q < 16; ++q) {
        const int jj = DIR ? 15 - q : q;
        const f32x2 x = *(const LAS f32x2*)(xr + jj * S5_XP);
        const float nr = lbr * sr - lbi * si + x[0], ni = lbr * si + lbi * sr + x[1]; sr = nr; si = ni;
        if (PASS2) *(LAS unsigned*)(sw + jj * 272) = cvtpk(sr, si);
    }
    if (PASS2) {
        asm volatile("s_waitcnt lgkmcnt(0)" ::: "memory");
        f32x4 acc = DIR ? yacc : (f32x4){0.f, 0.f, 0.f, 0.f};
        const LAS unsigned char* sa = slds + hq * 272 + kq * 16;
#pragma unroll
        for (int ks = 0; ks < 4; ++ks) { const bf16x8 a = *(const LAS bf16x8*)(sa + ks * 64); acc = __builtin_amdgcn_mfma_f32_16x16x32_bf16(a, bc[ks], acc, 0, 0, 0); }
        yacc = acc;
    }
    asm volatile("s_waitcnt lgkmcnt(0)" ::: "memory");
    __builtin_amdgcn_sched_barrier(0);
}
template <int DIR, bool PASS2>
__device__ __forceinline__ void s5_dir(LAS unsigned char* ulds, const bf16x8 (&bb)[8], const bf16x8 (&bc)[4], float lbr, float lbi, float& sr, float& si, f32x4 (&yacc)[8], int lane) {
    if constexpr (PASS2) {
#pragma unroll
        for (int sb = 0; sb < 8; ++sb) { const int sub = DIR ? 7 - sb : sb; s5_sub<DIR, true>(ulds, bb, bc, lbr, lbi, sr, si, yacc[sub], sub, lane); }
    } else {
#pragma unroll 1
        for (int sb = 0; sb < 8; ++sb) { const int sub = DIR ? 7 - sb : sb; s5_sub<DIR, false>(ulds, bb, bc, lbr, lbi, sr, si, yacc[0], sub, lane); }
    }
}

__device__ __forceinline__ void s5n_setup(PPtr P, int li, int dir, int g, int lane, float& lbr, float& lbi, bf16x8 (&bb)[8], LAS unsigned char* scr) {
    const size_t ga = ((size_t)(li * 2 + dir) * 32 + g);
    const float are = fminf(P->in[18][ga * 64 + lane], -1e-4f), aim = P->in[19][ga * 64 + lane]; const float dt = expf(P->in[20][ga]);
    const float mag = expf(are * dt); float sn, cn;
    { float xr_ = aim * dt * 0.15915494309189535f; xr_ -= __builtin_rintf(xr_); sn = __builtin_amdgcn_sinf(xr_); cn = __builtin_amdgcn_cosf(xr_); }
    lbr = mag * cn; lbi = mag * sn; const float den = are * are + aim * aim, nre = lbr - 1.f;
    const float fre = (nre * are + lbi * aim) / den, fim = (lbi * are - nre * aim) / den;
    const int hq = lane & 15, kq = lane >> 4, ri = lane & 1;
#pragma unroll 1
    for (int nt = 0; nt < 8; ++nt) {
        const int pp = 8 * nt + (hq >> 1); const float fr2 = __shfl(fre, pp), fi2 = __shfl(fim, pp);
        const int kq2 = kq & 1;
        const f32x4* br = (const f32x4*)(P->in[21] + (ga * 64 + pp) * 16 + 8 * kq2); const f32x4* bi = (const f32x4*)(P->in[22] + (ga * 64 + pp) * 16 + 8 * kq2);
        const f32x4 r0 = br[0], r1 = br[1], i0 = bi[0], i1 = bi[1]; float v[8];
#pragma unroll
        for (int e = 0; e < 4; ++e) { v[e] = ri ? (fr2 * i0[e] + fi2 * r0[e]) : (fr2 * r0[e] - fi2 * i0[e]); v[4 + e] = ri ? (fr2 * i1[e] + fi2 * r1[e]) : (fr2 * r1[e] - fi2 * i1[e]); }
        u32x4 w; w.x = cvtpk(v[0], v[1]); w.y = cvtpk(v[2], v[3]); w.z = cvtpk(v[4], v[5]); w.w = cvtpk(v[6], v[7]);
        if (kq >= 2) w = (u32x4){0u, 0u, 0u, 0u};
        *(LAS u32x4*)(scr + (nt * 64 + lane) * 16) = w;
    }
    asm volatile("s_waitcnt lgkmcnt(0)" ::: "memory");
#pragma unroll
    for (int nt = 0; nt < 8; ++nt) bb[nt] = *(const LAS bf16x8*)(scr + (nt * 64 + lane) * 16);
    asm volatile("s_waitcnt lgkmcnt(0)" ::: "memory");
}
__device__ __forceinline__ void s5n_stage_u(const bf16_t* proj, int b, int g, int ch, LAS unsigned char* ulds, int lane) {
    const bf16_t* src = proj + ((size_t)b * SEQL + (size_t)ch * S5_CH) * LDP + C_DU + g * 16;
#pragma unroll
    for (int it = 0; it < 4; ++it) { const int r = it * 32 + (lane >> 1), hf = lane & 1; *(LAS u32x4*)(ulds + r * 32 + hf * 16) = *(const u32x4*)(src + (size_t)r * LDP + hf * 8); }
    asm volatile("s_waitcnt vmcnt(0) lgkmcnt(0)" ::: "memory");
}
__device__ __forceinline__ void s5n_pass1(PPtr P, int li, LAS unsigned char* lds, int gw, int NGW, int wave, int lane) {
    LAS unsigned char* ulds = lds + wave * S5_WLDS; const bf16_t* proj = (const bf16_t*)(P->ws + OFF_PROJ); f32x2* carry = (f32x2*)(P->ws + OFF_CARRY);
    for (int item = gw; item < NBATCH * 32 * S5_NCH; item += NGW) {
        const int ch = item % S5_NCH, g = (item / S5_NCH) % 32, b = item / (S5_NCH * 32);
        s5n_stage_u(proj, b, g, ch, ulds, lane);
#pragma unroll 1
        for (int dir = 0; dir < 2; ++dir) {
            float lbr, lbi; bf16x8 bb[8], bc[4]; f32x4 ydummy[8];
            s5n_setup(P, li, dir, g, lane, lbr, lbi, bb, ulds + 4096);
            float sr = 0.f, si = 0.f;
            if (dir == 0) s5_dir<0, false>(ulds, bb, bc, lbr, lbi, sr, si, ydummy, lane); else s5_dir<1, false>(ulds, bb, bc, lbr, lbi, sr, si, ydummy, lane);
            carry[((((size_t)b * 32 + g) * S5_NCH + ch) * 2 + dir) * 64 + lane] = (f32x2){sr, si};
        }
    }
}

template <int DIR> __device__ __forceinline__ void s5_carry_in(const f32x2* cb, int ch, float lbr, float lbi, float& sr, float& si) {
    float cr = lbr, ci = lbi;
#pragma unroll
    for (int q = 0; q < 7; ++q) { const float nr = cr * cr - ci * ci, ni = 2.f * cr * ci; cr = nr; ci = ni; }
    sr = 0.f; si = 0.f;
    if (DIR == 0) {
#pragma unroll 4
        for (int c = 0; c < ch; ++c) { const f32x2 e = cb[(size_t)c * 128]; const float nr = cr * sr - ci * si + e[0], ni = cr * si + ci * sr + e[1]; sr = nr; si = ni; }
    } else {
#pragma unroll 4
        for (int c = S5_NCH - 1; c > ch; --c) { const f32x2 e = cb[(size_t)c * 128]; const float nr = cr * sr - ci * si + e[0], ni = cr * si + ci * sr + e[1]; sr = nr; si = ni; }
    }
}
__device__ __forceinline__ void s5h_pass2(PPtr P, int li, LAS unsigned char* lds, int gw, int NGW, int wave, int lane) {
    LAS unsigned char* ulds = lds + wave * S5_WLDS; bf16_t* proj = (bf16_t*)(P->ws + OFF_PROJ); const f32x2* carry = (const f32x2*)(P->ws + OFF_CARRY);
    const int hq = lane & 15, kq = lane >> 4;
    for (int item = gw; item < NBATCH * 32 * S5_NCH; item += NGW) {
        const int ch = item % S5_NCH, g = (item / S5_NCH) % 32, b = item / (S5_NCH * 32);
        s5n_stage_u(proj, b, g, ch, ulds, lane);
        bf16_t* dst = proj + ((size_t)b * SEQL + (size_t)ch * S5_CH) * LDP + C_DU + g * 16 + hq;
        const float dd = P->in[25][((size_t)li * 32 + g) * 16 + hq];
#pragma unroll 1
        for (int dir = 0; dir < 2; ++dir) {
            float lbr, lbi; bf16x8 bb[8], bc[4];
            s5n_setup(P, li, dir, g, lane, lbr, lbi, bb, ulds + 4096);
            { const size_t cbase = (((size_t)(li * 2 + dir) * 32 + g) * 16 + hq) * 64;
#pragma unroll
              for (int ks = 0; ks < 4; ++ks) { const f32x4 re = *(const f32x4*)(P->in[23] + cbase + 16 * ks + 4 * kq), im = *(const f32x4*)(P->in[24] + cbase + 16 * ks + 4 * kq);
                  u32x4 w; w.x = cvtpk(re[0], -im[0]); w.y = cvtpk(re[1], -im[1]); w.z = cvtpk(re[2], -im[2]); w.w = cvtpk(re[3], -im[3]); bc[ks] = __builtin_bit_cast(bf16x8, w); } }
            float sr, si;
            const f32x2* cb = carry + ((((size_t)b * 32 + g) * S5_NCH) * 2 + dir) * 64 + lane;
            if (dir == 0) s5_carry_in<0>(cb, ch, lbr, lbi, sr, si); else s5_carry_in<1>(cb, ch, lbr, lbi, sr, si);
#pragma unroll 1
            for (int sb = 0; sb < 8; ++sb) {
                const int sub = dir ? 7 - sb : sb;
                bf16_t* drow = dst + (size_t)(sub * 16 + 4 * kq) * LDP;
                float yf[4] = {0.f, 0.f, 0.f, 0.f};
                if (dir) {
#pragma unroll
                    for (int i = 0; i < 4; ++i) yf[i] = bf1(drow[(size_t)i * LDP]);
                }
                f32x4 acc = {0.f, 0.f, 0.f, 0.f};
                if (dir == 0) s5_sub<0, true>(ulds, bb, bc, lbr, lbi, sr, si, acc, sub, lane); else s5_sub<1, true>(ulds, bb, bc, lbr, lbi, sr, si, acc, sub, lane);
                if (dir == 0) {
#pragma unroll
                    for (int i = 0; i < 4; ++i) drow[(size_t)i * LDP] = tobf(acc[i]);
                } else {
#pragma unroll
                    for (int i = 0; i < 4; ++i) { const int r = sub * 16 + 4 * kq + i; const float uu = bf1(*(const LAS bf16_t*)(ulds + r * 32 + hq * 2)); const float y = acc[i] + yf[i] + dd * uu;
                        const float z = 1.5957691216057308f * (y + 0.044715f * y * y * y); drow[(size_t)i * LDP] = tobf(y * fsigmoid(z)); }
                }
            }
        }
        asm volatile("s_waitcnt vmcnt(0) lgkmcnt(0)" ::: "memory");
    }
}

typedef short v4i16_t __attribute__((ext_vector_type(4)));
__device__ __forceinline__ float other_half(float v) { unsigned a = __builtin_bit_cast(unsigned, v), b = a; asm volatile("" : "+v"(b)); auto rr = __builtin_amdgcn_permlane32_swap(a, b, false, false);
    const float x = __builtin_bit_cast(float, rr[0]), y = __builtin_bit_cast(float, rr[1]); return (threadIdx.x & 32) ? x : y; }
__device__ __forceinline__ float max3f(float a, float b, float c) { float r; asm("v_max3_f32 %0, %1, %2, %3" : "=v"(r) : "v"(a), "v"(b), "v"(c)); return r; }
__device__ __forceinline__ bf16x8 scale_frag(bf16x8 f, float c) { const u32x4 w = __builtin_bit_cast(u32x4, f); u32x4 o;
    o.x = cvtpk(bflo(w.x) * c, bfhi(w.x) * c); o.y = cvtpk(bflo(w.y) * c, bfhi(w.y) * c); o.z = cvtpk(bflo(w.z) * c, bfhi(w.z) * c); o.w = cvtpk(bflo(w.w) * c, bfhi(w.w) * c); return __builtin_bit_cast(bf16x8, o); }
template <int DQK, int DV, bool BIAS>
__device__ __forceinline__ void attn_pass(LAS unsigned char* lds, const bf16_t* Qw, int ldq, const bf16_t* Q2w, int ldq2, const bf16_t* Kg, int ldk, const bf16_t* K2g, int ldk2,
                                          const bf16_t* Vg, int ldv, int qpos0, float cs, float sl2, const float* ropetab, f32x16 (&o)[DV / 32]) {
    constexpr int KP = DQK * 2 + 16, KBUF = 64 * KP, VBUF = (DV / 32) * 4096, NKS = DQK / 16, NDT = DV / 32, NVL = DV / 64, VOFF = ((DV == 64) ? 4 : 2) * KBUF;
    int tid_ = threadIdx.x; asm volatile("" : "+v"(tid_));
    const int tid = tid_, lane = tid & 63, r32 = lane & 31, hi = lane >> 5;
    const bool isY = false;
    bf16x8 qf[NKS];
#pragma unroll
    for (int ks = 0; ks < NKS; ++ks) qf[ks] = ks < 4 ? *(const bf16x8*)(Qw + (size_t)r32 * ldq + ks * 16 + hi * 8) : *(const bf16x8*)(Q2w + (size_t)r32 * ldq2 + (ks - 4) * 16 + hi * 8);
#pragma unroll
    for (int ks = 0; ks < 4; ++ks) qf[ks] = scale_frag(qf[ks], cs);
    if constexpr (DQK == 96) {
        const float* rp = ropetab + ((size_t)(qpos0 + r32) * 16) * 2;
#pragma unroll
        for (int ks = 4; ks < 6; ++ks) {
            const f32x4 c0 = *(const f32x4*)(rp + ((ks - 4) * 8 + hi * 4) * 2), c1 = *(const f32x4*)(rp + ((ks - 4) * 8 + hi * 4 + 2) * 2);
            const u32x4 w = __builtin_bit_cast(u32x4, qf[ks]); u32x4 ow;
            { const float a = bflo(w.x) * cs, b = bfhi(w.x) * cs; ow.x = cvtpk(a * c0[0] - b * c0[1], a * c0[1] + b * c0[0]); }
            { const float a = bflo(w.y) * cs, b = bfhi(w.y) * cs; ow.y = cvtpk(a * c0[2] - b * c0[3], a * c0[3] + b * c0[2]); }
            { const float a = bflo(w.z) * cs, b = bfhi(w.z) * cs; ow.z = cvtpk(a * c1[0] - b * c1[1], a * c1[1] + b * c1[0]); }
            { const float a = bflo(w.w) * cs, b = bfhi(w.w) * cs; ow.w = cvtpk(a * c1[2] - b * c1[3], a * c1[3] + b * c1[2]); }
            qf[ks] = __builtin_bit_cast(bf16x8, ow);
        }
    }
#pragma unroll
    for (int d = 0; d < NDT; ++d)
#pragma unroll
        for (int r = 0; r < 16; ++r) o[d][r] = 0.f;
#pragma unroll
    for (int ks = 0; ks < NKS; ++ks) asm volatile("" : "+v"(qf[ks]));
    float mhat = 0.f, l = 0.f; f32x16 negm;
#pragma unroll
    for (int r = 0; r < 16; ++r) negm[r] = 0.f;
    constexpr int TPB = (DV == 64) ? 2 : 1, NG = SEQL / 64 / TPB;
    u32x4 kreg[TPB], k2reg[TPB], vreg[TPB][NVL];
    const bf16_t* kptr = Kg + (size_t)(tid >> 3) * ldk + (tid & 7) * 8;
    const bf16_t* k2ptr = (DQK == 96) ? K2g + (size_t)(tid >> 2) * ldk2 + (tid & 3) * 8 : nullptr;
#define ATT_LOAD(t, j_) do { kreg[j_] = *(const u32x4*)(kptr + (size_t)(t) * 64 * ldk); \
        if (DQK == 96) { if (tid < 256) k2reg[j_] = *(const u32x4*)(k2ptr + (size_t)(t) * 64 * ldk2); } \
        _Pragma("unroll") for (int i_ = 0; i_ < NVL; ++i_) { const int idx_ = tid + 512 * i_; vreg[j_][i_] = *(const u32x4*)(Vg + (size_t)((t) * 64 + ((idx_ & 255) >> 2)) * ldv + (idx_ >> 8) * 32 + (idx_ & 3) * 8); } } while (0)
#define ATT_STORE(sl_, j_) do { *(LAS u32x4*)(lds + (sl_) * KBUF + (tid >> 3) * KP + (tid & 7) * 16) = kreg[j_]; \
        if (DQK == 96) { if (tid < 256) *(LAS u32x4*)(lds + (sl_) * KBUF + (tid >> 2) * KP + 128 + (tid & 3) * 16) = k2reg[j_]; } \
        _Pragma("unroll") for (int i_ = 0; i_ < NVL; ++i_) { const int idx_ = tid + 512 * i_; *(LAS u32x4*)(lds + VOFF + (sl_) * VBUF + (idx_ >> 8) * 4096 + ((idx_ & 255) >> 2) * 64 + (idx_ & 3) * 16) = vreg[j_][i_]; } } while (0)
    u32x4 pw[4];
#pragma unroll
    for (int j = 0; j < TPB; ++j) { ATT_LOAD(j, j); ATT_STORE(j, j); }
#pragma unroll
    for (int j = 0; j < TPB; ++j) ATT_LOAD(TPB + j, j);
    const float qp = (float)(qpos0 + r32);
#pragma unroll 4
    for (int g = 0; g < NG; ++g) {
        const int pair = g & 1;
        __syncthreads();
        if (g + 1 < NG) {
#pragma unroll
            for (int j = 0; j < TPB; ++j) ATT_STORE((pair ^ 1) * TPB + j, j);
            if (g + 2 < NG) {
#pragma unroll
                for (int j = 0; j < TPB; ++j) ATT_LOAD((g + 2) * TPB + j, j);
            }
        }
#pragma unroll
      for (int sub = 0; sub < TPB; ++sub) {
        const int t = g * TPB + sub, buf = pair * TPB + sub, vcur = buf;
        f32x16 p0, p1;
        const LAS unsigned char* kb = lds + buf * KBUF + r32 * KP + hi * 16;
#pragma unroll
        for (int ks = 0; ks < NKS; ++ks) {
            const bf16x8 k0 = *(const LAS bf16x8*)(kb + ks * 32), k1 = *(const LAS bf16x8*)(kb + 32 * KP + ks * 32);
            if (ks == 0) { p0 = __builtin_amdgcn_mfma_f32_32x32x16_bf16(k0, qf[0], negm, 0, 0, 0); p1 = __builtin_amdgcn_mfma_f32_32x32x16_bf16(k1, qf[0], negm, 0, 0, 0); }
            else { p0 = __builtin_amdgcn_mfma_f32_32x32x16_bf16(k0, qf[ks], p0, 0, 0, 0); p1 = __builtin_amdgcn_mfma_f32_32x32x16_bf16(k1, qf[ks], p1, 0, 0, 0); }
        }
        if (BIAS) {
            asm volatile("s_nop 15\n\ts_nop 7" : "+v"(p0), "+v"(p1));
            const float d0 = qp - (float)(t * 64 + 4 * hi);
#pragma unroll
            for (int r = 0; r < 16; ++r) { const float dk = d0 - (float)((r & 3) + 8 * (r >> 2)); p0[r] = p0[r] - sl2 * fabsf(dk); p1[r] = p1[r] - sl2 * fabsf(dk - 32.f); }
        } else {
            asm volatile("s_nop 15\n\ts_nop 7" : "+v"(p0), "+v"(p1));
        }
        float mxa = max3f(p0[0], p0[1], p1[0]), mxb = max3f(p0[2], p0[3], p1[1]); mxa = max3f(mxa, p1[2], p1[3]);
#pragma unroll
        for (int r = 4; r < 16; r += 4) { mxa = max3f(mxa, p0[r], p0[r + 1]); mxb = max3f(mxb, p0[r + 2], p0[r + 3]); mxa = max3f(mxa, p1[r], p1[r + 1]); mxb = max3f(mxb, p1[r + 2], p1[r + 3]); }
        float mx = fmaxf(mxa, mxb);
        if (__any(mx > 8.f)) {
            mx = fmaxf(mx, __shfl_xor(mx, 32));
            const float dl = fmaxf(mx, 0.f); mhat += dl;
            const float f = __builtin_amdgcn_exp2f(-dl);
#pragma unroll
            for (int r = 0; r < 16; ++r) { p0[r] -= dl; p1[r] -= dl; negm[r] = -mhat; }
            l *= f;
#pragma unroll
            for (int d = 0; d < NDT; ++d)
#pragma unroll
                for (int r = 0; r < 16; ++r) o[d][r] *= f;
        }
        if (!isY) {
            const LAS unsigned char* vbase = lds + VOFF + vcur * VBUF + (4 * hi + ((lane & 15) >> 2)) * 64 + ((lane >> 4) & 1) * 32 + (lane & 3) * 8;
            float ls = 0.f;
#pragma unroll
            for (int hs = 0; hs < 4; ++hs) {
                float e[8];
#pragma unroll
                for (int j = 0; j < 8; ++j) { e[j] = __builtin_amdgcn_exp2f(hs < 2 ? p0[8 * (hs & 1) + j] : p1[8 * (hs & 1) + j]); ls += e[j]; }
                pw[hs].x = cvtpk(e[0], e[1]); pw[hs].y = cvtpk(e[2], e[3]); pw[hs].z = cvtpk(e[4], e[5]); pw[hs].w = cvtpk(e[6], e[7]);
                const bf16x8 pbv = __builtin_bit_cast(bf16x8, pw[hs]);
#pragma unroll
                for (int d = 0; d < NDT; ++d) { const LAS unsigned char* vp = vbase + d * 4096 + hs * 1024;
                    const v4i16_t a0 = __builtin_amdgcn_ds_read_tr16_b64_v4i16((LAS v4i16_t*)vp), a1 = __builtin_amdgcn_ds_read_tr16_b64_v4i16((LAS v4i16_t*)(vp + 512));
                    const bf16x8 av = {a0[0], a0[1], a0[2], a0[3], a1[0], a1[1], a1[2], a1[3]};
                    o[d] = __builtin_amdgcn_mfma_f32_32x32x16_bf16(av, pbv, o[d], 0, 0, 0); }
                __builtin_amdgcn_sched_barrier(0);
            }
            l += ls;
        } else {
            float ls = 0.f;
#pragma unroll
            for (int r = 0; r < 16; ++r) { p0[r] = __builtin_amdgcn_exp2f(p0[r]); p1[r] = __builtin_amdgcn_exp2f(p1[r]); ls += p0[r] + p1[r]; }
            l += ls;
#pragma unroll
            for (int s = 0; s < 2; ++s) {
                pw[s].x = cvtpk(p0[8 * s + 0], p0[8 * s + 1]); pw[s].y = cvtpk(p0[8 * s + 2], p0[8 * s + 3]); pw[s].z = cvtpk(p0[8 * s + 4], p0[8 * s + 5]); pw[s].w = cvtpk(p0[8 * s + 6], p0[8 * s + 7]);
                pw[2 + s].x = cvtpk(p1[8 * s + 0], p1[8 * s + 1]); pw[2 + s].y = cvtpk(p1[8 * s + 2], p1[8 * s + 3]); pw[2 + s].z = cvtpk(p1[8 * s + 4], p1[8 * s + 5]); pw[2 + s].w = cvtpk(p1[8 * s + 6], p1[8 * s + 7]);
            }
        }
      }
    }
    __syncthreads();
#undef ATT_LOAD
#undef ATT_STORE
#undef ATT_PV
    l += __shfl_xor(l, 32);
    const float inv = 1.f / l;
#pragma unroll
    for (int d = 0; d < NDT; ++d)
#pragma unroll
        for (int r = 0; r < 16; ++r) o[d][r] *= inv;
}
template <int NDT> __device__ __forceinline__ void attn_store(const f32x16 (&o)[NDT], bf16_t* Ow, int ldo, int r32, int hi) {
#pragma unroll
    for (int d = 0; d < NDT; ++d)
#pragma unroll
        for (int q = 0; q < 4; ++q) { u32x2 w; w.x = cvtpk(o[d][4 * q], o[d][4 * q + 1]); w.y = cvtpk(o[d][4 * q + 2], o[d][4 * q + 3]); *(u32x2*)(Ow + (size_t)r32 * ldo + 32 * d + 8 * q + 4 * hi) = w; }
}
__device__ __forceinline__ void attn_phase(PPtr P, int li, LAS unsigned char* lds, int vcu, int wave, int lane) {
    bf16_t* proj = (bf16_t*)(P->ws + OFF_PROJ); bf16_t* mlaq = (bf16_t*)(P->ws + OFF_MLAQ); const bf16_t* mlakv = (const bf16_t*)(P->ws + OFF_MLAKV);
    const int r32 = lane & 31, hi = lane >> 5;
    {
        const int b = vcu >> 6, h = (vcu >> 4) & 3, qb = vcu & 15;
        const size_t seq0 = (size_t)b * SEQL, qrow = seq0 + qb * 256 + wave * 32;
        const float slope = __builtin_amdgcn_exp2f(-2.f * (float)(h + 1));
        f32x16 o1[4], o2[4];
        attn_pass<64, 128, true>(lds, proj + qrow * LDP + C_AQ + h * 128, LDP, nullptr, 0, proj + seq0 * LDP + C_AK + h * 128, LDP, nullptr, 0, proj + seq0 * LDP + C_AV + h * 128, LDP, qb * 256 + wave * 32, 0.125f * LOG2E, slope * LOG2E, nullptr, o1);
        LAS unsigned* o1s = (LAS unsigned*)(lds + 81920 + wave * 8192) + lane;
#pragma unroll
        for (int d = 0; d < 4; ++d)
#pragma unroll
            for (int r = 0; r < 8; ++r) o1s[(d * 8 + r) * 64] = cvtpk(o1[d][2 * r], o1[d][2 * r + 1]);
        attn_pass<64, 128, true>(lds, proj + qrow * LDP + C_AQ + h * 128 + 64, LDP, nullptr, 0, proj + seq0 * LDP + C_AK + h * 128 + 64, LDP, nullptr, 0, proj + seq0 * LDP + C_AV + h * 128, LDP, qb * 256 + wave * 32, 0.125f * LOG2E, slope * LOG2E, nullptr, o2);
        const float s1 = wave_sum(P->in[7][li * 64 + lane] * P->in[8][li * 64 + lane]), s2 = wave_sum(P->in[9][li * 64 + lane] * P->in[10][li * 64 + lane]);
        const float lam_init = 0.8f - 0.6f * expf(-0.3f * (float)li); const float lam = expf(s1) - expf(s2) + lam_init;
        float ss = 0.f;
#pragma unroll
        for (int d = 0; d < 4; ++d)
#pragma unroll
            for (int r = 0; r < 8; ++r) { const unsigned w = o1s[(d * 8 + r) * 64]; const float v0 = bflo(w) - lam * o2[d][2 * r], v1 = bfhi(w) - lam * o2[d][2 * r + 1]; o1[d][2 * r] = v0; o1[d][2 * r + 1] = v1; ss += v0 * v0 + v1 * v1; }
        ss += __shfl_xor(ss, 32);
        const float rs = __builtin_amdgcn_rsqf(ss * (1.f / 128) + EPSN) * (1.f - lam_init);
        const float* sub = P->in[11] + li * 128;
#pragma unroll
        for (int d = 0; d < 4; ++d)
#pragma unroll
            for (int q = 0; q < 4; ++q) { const f32x4 gg = *(const f32x4*)(sub + 32 * d + 8 * q + 4 * hi);
                o1[d][4 * q] *= rs * gg[0]; o1[d][4 * q + 1] *= rs * gg[1]; o1[d][4 * q + 2] *= rs * gg[2]; o1[d][4 * q + 3] *= rs * gg[3]; }
        attn_store<4>(o1, proj + qrow * LDP + C_AQ + h * 128, LDP, r32, hi);
    }
#pragma unroll 1
    for (int k = 0; k < 2; ++k) {
        const int idx = vcu + 256 * k; const int b = idx >> 7, qh = (idx >> 4) & 7, qb = idx & 15, kvh = qh >> 2;
        const size_t seq0 = (size_t)b * SEQL, qrow = seq0 + qb * 256 + wave * 32;
        f32x16 o[2];
        attn_pass<64, 64, false>(lds, proj + qrow * LDP + C_BQ + qh * 64, LDP, nullptr, 0, proj + seq0 * LDP + C_BK + kvh * 64, LDP, nullptr, 0, proj + seq0 * LDP + C_BV + kvh * 64, LDP, 0, 0.125f * LOG2E, 0.f, nullptr, o);
        attn_store<2>(o, proj + qrow * LDP + C_BQ + qh * 64, LDP, r32, hi);
    }
#pragma unroll 1
    for (int k = 0; k < 2; ++k) {
        const int idx = vcu + 256 * k; const int b = idx >> 7, h = (idx >> 4) & 7, qb = idx & 15;
        const size_t seq0 = (size_t)b * SEQL, qrow = seq0 + qb * 256 + wave * 32;
        f32x16 o[2];
        attn_pass<96, 64, false>(lds, mlaq + qrow * 768 + h * 64, 768, mlaq + qrow * 768 + 512 + h * 32, 768, mlakv + seq0 * 1024 + h * 128, 1024, proj + seq0 * LDP + C_CKR, LDP,
                                 mlakv + seq0 * 1024 + h * 128 + 64, 1024, qb * 256 + wave * 32, 0.10206207261596575f * LOG2E, 0.f, (const float*)(P->ws + OFF_ROPE), o);
        attn_store<2>(o, mlaq + qrow * 768 + h * 64, 768, r32, hi);
    }
}

#define XB_TMO      128
#define XB_XCNT(j)  (256  + 64 * (j))
#define XB_XSUB(j)  (1280 + 64 * (j))
#define XB_XGEN(j)  (2304 + 64 * (j))
#define XB_TOP      3328
#define XB_TOPGEN   3392
#define XCD_BAR_WORDS 3456
#define XB_SPIN_CAP (1u << 18)

__device__ __forceinline__ unsigned xb_ld(unsigned* p)              { return __hip_atomic_load(p, __ATOMIC_RELAXED, __HIP_MEMORY_SCOPE_AGENT); }
__device__ __forceinline__ unsigned xb_add(unsigned* p, unsigned v) { return __hip_atomic_fetch_add(p, v, __ATOMIC_RELAXED, __HIP_MEMORY_SCOPE_AGENT); }
__device__ __forceinline__ unsigned xb_xcc_id() { return (unsigned)__builtin_amdgcn_s_getreg((3 << 11) | 20) & 0xFu; }
#define XB_SPIN(cond, bar) do { unsigned _sp = 0; while (cond) { __builtin_amdgcn_s_sleep(1); \
    if ((++_sp & 255u) == 0u) { if (xb_ld(&(bar)[XB_TMO])) break; if (_sp > XB_SPIN_CAP) { atomicAdd(&(bar)[XB_TMO], 1u); break; } } } } while (0)

struct XcdBarrier {
    unsigned* bar; unsigned x;
    volatile LAS unsigned* st;
};

__device__ __forceinline__ XcdBarrier xcd_barrier_post(unsigned* bar, volatile LAS unsigned* st) {
    XcdBarrier b; b.bar = bar; b.x = xb_xcc_id(); b.st = st;
    if (threadIdx.x == 0) (void)xb_add(&bar[XB_XCNT(b.x)], 1u);
    return b;
}
__device__ __forceinline__ void xcd_barrier_complete(unsigned* bar, unsigned x, unsigned& nloc, unsigned& nx) {
    const unsigned G = gridDim.x * gridDim.y * gridDim.z;
    unsigned sum, cnt, mine, sp = 0u;
    for (;;) {
        sum = 0u; cnt = 0u; mine = 0u;
#pragma unroll
        for (unsigned j = 0; j < 16; ++j) { const unsigned c = xb_ld(&bar[XB_XCNT(j)]); sum += c; cnt += (c > 0u) ? 1u : 0u; mine = (j == x) ? c : mine; }
        if (sum == G) break;
        __builtin_amdgcn_s_sleep(1);
        if ((++sp & 255u) == 0u) { if (xb_ld(&bar[XB_TMO])) break; if (sp > XB_SPIN_CAP) { atomicAdd(&bar[XB_TMO], 1u); break; } }
    }
    nloc = mine > 0u ? mine : 1u; nx = cnt > 0u ? cnt : 1u;
}

__device__ __forceinline__ void xcd_barrier(const XcdBarrier& b) {
    asm volatile("s_waitcnt vmcnt(0)" ::: "memory");
    __syncthreads();
    if (threadIdx.x == 0) {
        unsigned* bar = b.bar;
        __builtin_amdgcn_s_waitcnt(0);
        unsigned nloc = b.st[0], nx = b.st[1];
        if (nloc == 0u) { xcd_barrier_complete(bar, b.x, nloc, nx); b.st[0] = nloc; b.st[1] = nx; }
        const unsigned old = xb_add(&bar[XB_XSUB(b.x)], 1u);
        const unsigned gen = old / nloc;
        if (old + 1u == (gen + 1u) * nloc) {
            __builtin_amdgcn_fence(__ATOMIC_RELEASE, "agent");
            asm volatile("s_waitcnt vmcnt(0)" ::: "memory");
            const unsigned og = xb_add(&bar[XB_TOP], 1u);
            const unsigned tg = og / nx;
            if (og + 1u == (tg + 1u) * nx) xb_add(&bar[XB_TOPGEN], 1u);
            else XB_SPIN(xb_ld(&bar[XB_TOPGEN]) == tg, bar);
            __builtin_amdgcn_fence(__ATOMIC_ACQUIRE, "agent");
            xb_add(&bar[XB_XGEN(b.x)], 1u);
            asm volatile("s_waitcnt vmcnt(0)" ::: "memory");
        } else {
            XB_SPIN(xb_ld(&bar[XB_XGEN(b.x)]) == gen, bar);
            __builtin_amdgcn_fence(__ATOMIC_ACQUIRE, "agent");
            asm volatile("s_waitcnt vmcnt(0)" ::: "memory");
        }
    }
    __syncthreads();
}

template <int ph> __device__ __forceinline__ void phase_body(LAS unsigned char* lds, int vcu, int NGW) {
        PPtr P = (PPtr)__builtin_amdgcn_kernarg_segment_ptr(); asm volatile("" : "+s"(P));
        bf16_t* proj = (bf16_t*)(P->ws + OFF_PROJ); bf16_t* mlaq = (bf16_t*)(P->ws + OFF_MLAQ); bf16_t* mlakv = (bf16_t*)(P->ws + OFF_MLAKV); bf16_t* xn = (bf16_t*)(P->ws + OFF_XN); bf16_t* yd = (bf16_t*)(P->ws + OFF_YD);
        const bf16_t* Wb = (const bf16_t*)(P->ws + OFF_W); float* rope = (float*)(P->ws + OFF_ROPE);
        bf16_t* hid = proj; bf16_t* mixed = mlakv; bf16_t* tmp1 = proj; bf16_t* tmp2 = xn; bf16_t* gatebuf = proj + C_AK;
        int tid_ = threadIdx.x; asm volatile("" : "+v"(tid_));
        const int lane = tid_ & 63, wave = __builtin_amdgcn_readfirstlane(tid_ >> 6), gw = vcu * 8 + wave;
        if constexpr (ph == 0) { if (PHON(0)) {
            const float invf[16] = {1.0f, 0.5623413324356079f, 0.3162277638912201f, 0.17782793939113617f, 0.10000000149011612f, 0.05623413249850273f, 0.03162277489900589f, 0.017782794311642647f,
                                    0.009999999776482582f, 0.005623413249850273f, 0.003162277629598975f, 0.0017782794311642647f, 0.0010000000474974513f, 0.000562341301701963f, 0.0003162277571391314f, 0.00017782794020604342f};
            for (int i = gw * 64 + lane; i < SEQL * 16; i += NGW * 64) {
                const int j = i & 15; float fv = invf[0];
#pragma unroll
                for (int q = 1; q < 16; ++q) fv = (j == q) ? invf[q] : fv;
                const float ang = (float)(i >> 4) * fv; float s, c; sincos_d((double)ang, s, c); rope[2 * i] = c; rope[2 * i + 1] = s;
            }
            convert_weights(P, 0, lds, gw, NGW, wave, lane);
            prenorm_rows(P->in[0], P->in[1], xn, gw, NGW, lane); }
        } else {
            constexpr int li = (ph - 1) / 10, k = (ph - 1) % 10 + 1;
            if constexpr (k == 1) { if (PHON(1)) {
                EpiB<0> E{proj, LDP, LDP, nullptr, 0, nullptr};
                run_gemm<0>(lds, xn, 1024, Wb + W_IN, 1024, NTOK, NPAD_IN, 1024, E);
            } } else if constexpr (k == 2) { if (PHON(2)) {
                prep_rows(proj, P->in[12] + li * 64, P->in[13] + li * 64, P->in[14] + li * 256, P->in[15] + li * 128, rope, gw, NGW, lane);
                s5n_pass1(P, li, lds, gw, NGW, wave, lane);
            } } else if constexpr (k == 3) { if (PHON(3)) {
#ifndef NO_G3
                { EpiB<0> E{mlaq, 768, 768, nullptr, 0, nullptr}; run_gemm<0>(lds, proj + C_CQ, LDP, Wb + W_UQ, 256, NTOK, 768, 256, E); }
                { EpiB<0> E{mlakv, 1024, 1024, nullptr, 0, nullptr}; run_gemm<0>(lds, proj + C_CKV, LDP, Wb + W_UKV, 128, NTOK, 1024, 128, E); }
#endif
#ifndef NO_S5P2
                s5h_pass2(P, li, lds, gw, NGW, wave, lane);
#endif
            } } else if constexpr (k == 4) { if (PHON(4)) {
#ifndef NO_ATTN
                attn_phase(P, li, lds, vcu, wave, lane);
#endif
                __syncthreads();
#ifndef NO_GLU
                { EpiB<3> E{yd, 512, 512, nullptr, 0, nullptr}; run_gemm<3>(lds, proj + C_DU, LDP, Wb + W_GLU, 512, NTOK, 1024, 512, E); }
#endif
            } } else if constexpr (k == 5) { if (PHON(5)) {
#pragma unroll 1
                for (int b = 0; b < 4; ++b) {
                    { EpiB<1> E{gatebuf, LDP, 1024, nullptr, 0, nullptr}; run_gemm<1>(lds, xn, 1024, Wb + W_GATE + (size_t)b * 1024 * 1024, 1024, NTOK, 1024, 1024, E); }
                    const bf16_t* ya = b == 0 ? proj + C_AQ : b == 1 ? proj + C_BQ : b == 2 ? mlaq : yd; const int lda = b < 2 ? LDP : b == 2 ? 768 : 512;
                    if (b == 0) { EpiB<4> E{mixed, 1024, 1024, gatebuf, LDP, nullptr}; run_gemm<4>(lds, ya, lda, Wb + W_BR + (size_t)b * 524288, 512, NTOK, 1024, 512, E); }
                    else { EpiB<5> E{mixed, 1024, 1024, gatebuf, LDP, nullptr}; run_gemm<5>(lds, ya, lda, Wb + W_BR + (size_t)b * 524288, 512, NTOK, 1024, 512, E); }
                }
            } } else if constexpr (k == 6) { if (PHON(6)) {
                EpiB<0> E{tmp1, 1024, 1024, nullptr, 0, nullptr}; run_gemm<0>(lds, mixed, 1024, Wb + W_OUT, 1024, NTOK, 1024, 1024, E);
            } } else if constexpr (k == 7) { if (PHON(7)) {
                resnorm_rows(li == 0 ? P->in[0] : P->out, tmp1, P->in[2] + li * 1024, P->out, P->in[3] + li * 1024, xn, gw, NGW, lane);
            } } else if constexpr (k == 8) { if (PHON(8)) {
                EpiB<2> E{hid, 4096, 4096, nullptr, 0, nullptr}; run_gemm<2>(lds, xn, 1024, Wb + W_F1, 1024, NTOK, 4096, 1024, E);
            } } else if constexpr (k == 9) { if (PHON(9)) {
                EpiB<0> E{tmp2, 1024, 1024, nullptr, 0, nullptr}; run_gemm<0>(lds, hid, 4096, Wb + W_F2, 4096, NTOK, 1024, 4096, E);
            } } else { if (PHON(10)) {
                const bool last = (li == DEPTH_ - 1);
                resnorm_rows(P->out, tmp2, P->in[4] + li * 1024, P->out, last ? nullptr : P->in[1] + (li + 1) * 1024, xn, gw, NGW, lane);
                if (!last) convert_weights(P, li + 1, lds, gw, NGW, wave, lane);
            } }
        }
}
__global__ void __launch_bounds__(512, 2) fwd_mega(Params Pv) {
    extern __shared__ __attribute__((aligned(16))) unsigned char lds_raw[];
    LAS unsigned char* lds = (LAS unsigned char*)lds_raw;
    const int G = gridDim.x, bx = blockIdx.x; const int vcu = (G % 8 == 0) ? (bx % 8) * (G / 8) + bx / 8 : bx; const int NGW = G * 8;
    const int ph_lo = Pv.ph_lo, ph_hi = Pv.ph_hi;
    volatile LAS unsigned* bst = (volatile LAS unsigned*)(lds + 147456);
    if (threadIdx.x < 2) bst[threadIdx.x] = 0u;
    __syncthreads();
    XcdBarrier xbar = xcd_barrier_post((unsigned*)(Pv.ws + OFF_CTL), bst);
#define PHASE(n) if (ph_lo <= (n) && (n) < ph_hi) { phase_body<n>(lds, vcu, NGW); if ((n) + 1 < ph_hi) { if (ph_hi > NPHASE) { __syncthreads(); cg::this_grid().sync(); } else xcd_barrier(xbar); } }
    PHASE(0) PHASE(1) PHASE(2) PHASE(3) PHASE(4) PHASE(5) PHASE(6) PHASE(7) PHASE(8) PHASE(9) PHASE(10)
    PHASE(11) PHASE(12) PHASE(13) PHASE(14) PHASE(15) PHASE(16) PHASE(17) PHASE(18) PHASE(19) PHASE(20)
#undef PHASE
}

extern "C" void kernel_launch(void* const* d_in, const int* in_sizes, int n_in, void* d_out, int out_size, void* d_ws, size_t ws_size, hipStream_t stream) {
    static int ready = 0;
    if (!ready) {
        if (n_in != 34 || out_size != NTOK * DMODEL || ws_size < WS_NEED) { fprintf(stderr, "kernel_launch: unexpected shapes (n_in %d out %d ws %zu)\n", n_in, out_size, ws_size); ready = -1; return; }
        if (hipFuncSetAttribute((const void*)fwd_mega, hipFuncAttributeMaxDynamicSharedMemorySize, LDS_BYTES) != hipSuccess) { fprintf(stderr, "kernel_launch: hipFuncSetAttribute failed\n"); ready = -1; return; }
        int per_cu = 0; (void)hipOccupancyMaxActiveBlocksPerMultiprocessor(&per_cu, (const void*)fwd_mega, 512, LDS_BYTES); (void)hipGetLastError();
        if (per_cu < 1) fprintf(stderr, "kernel_launch: occupancy query says %d blocks per CU\n", per_cu);
        ready = 1;
    }
    if (ready < 0) return;
    Params p{};
    for (int i = 0; i < 34; ++i) p.in[i] = (const float*)d_in[i];
    p.out = (float*)d_out; p.ws = (unsigned char*)d_ws;
#if MK_ONE_LAUNCH
    p.ph_lo = 0; p.ph_hi = NPHASE;
    if (hipMemsetAsync((char*)d_ws + OFF_CTL, 0, CTL_BYTES, stream) != hipSuccess) { fprintf(stderr, "kernel_launch: hipMemsetAsync failed\n"); return; }
    void* args[] = {&p};
    hipError_t e = hipLaunchCooperativeKernel((const void*)fwd_mega, dim3(256), dim3(512), args, LDS_BYTES, stream);
    if (e != hipSuccess) fprintf(stderr, "cooperative launch failed: %s\n", hipGetErrorString(e));
#else
    for (int ph = 0; ph < NPHASE; ++ph) { p.ph_lo = ph; p.ph_hi = ph + 1; hipLaunchKernelGGL(fwd_mega, dim3(256), dim3(512), LDS_BYTES, stream, p); }
#endif
}
```
